# Optimizing an MI355X kernel written in HIP

```python
import jax
import jax.numpy as jnp
from jax import lax
import numpy as np

D_MODEL = 1024
BATCH = 32
SEQ = 256
DEPTH = 2
DEC_BATCH = 2
DEC_SEQ = 1024
PAST_LEN = 256

GRID_W = 64
EPS = 1e-6
N_MOD = 6
SSD_HEADDIM = 64
SSD_HEADS = D_MODEL // SSD_HEADDIM
SSD_INNER = SSD_HEADS * SSD_HEADDIM
SSD_GROUPS = 2
SSD_STATE = 128
SSD_CONV_W = 3
SSD_CHUNK = 128
SSD_XBC = SSD_INNER + 2 * SSD_GROUPS * SSD_STATE
SC_WIDTH = D_MODEL
SC_CONV_W = 3
MIX0_IN = SSD_INNER + SSD_XBC + 2 * SSD_HEADS + 3 * SC_WIDTH
MIX0_OUT = SSD_INNER + SC_WIDTH
NA_HEAD_DIM = 64
NA_HEADS = D_MODEL // NA_HEAD_DIM
NA_INNER = NA_HEADS * NA_HEAD_DIM
NA_KH = 8
NA_KW = 16
Q_BLOCK = 128
D_FF = ((8 * D_MODEL // 3 + 255) // 256) * 256
FFN_CONV_W = 3
N_SSD_LAYERS = (DEPTH + 1) // 2
N_NA_LAYERS = DEPTH // 2

kernel_name = 'hybrid_ssd_conv_natten_prefix_dit_step'


def rmsnorm(x, g):
    xf = x.astype(jnp.float32)
    y = xf * lax.rsqrt(jnp.mean(xf * xf, axis=-1, keepdims=True) + EPS)
    return (y * g.astype(jnp.float32)).astype(x.dtype)


def dwconv(x, w):
    k, ch = w.shape
    pl = (k - 1) // 2
    return lax.conv_general_dilated(x, w[:, None, :].astype(x.dtype), window_strides=(1,),
                                    padding=[(pl, k - 1 - pl)], dimension_numbers=('NWC', 'WIO', 'NWC'),
                                    feature_group_count=ch)


def ssd_scan(x, dt, a, bm, cm, h0):
    b, l, h, p = x.shape
    nc = l // SSD_CHUNK

    def chunks(t):
        return t.reshape((b, nc, SSD_CHUNK) + t.shape[2:])

    xd = chunks(x * dt[..., None])
    bm, cm = chunks(bm), chunks(cm)
    a_cs = jnp.cumsum(jnp.moveaxis(chunks(dt * a), -1, 1), axis=-1)
    causal = jnp.tril(jnp.ones((SSD_CHUNK, SSD_CHUNK), dtype=bool))
    seg = a_cs[..., :, None] - a_cs[..., None, :]
    decay = jnp.where(causal, jnp.exp(jnp.where(causal, seg, 0.0)), 0.0)
    cb = jnp.einsum('bclhn,bcshn->bhcls', cm, bm) * decay
    y = jnp.einsum('bhcls,bcshp->bclhp', cb, xd)
    to_end = jnp.exp(a_cs[..., -1:] - a_cs)
    st = jnp.einsum('bclhn,bhcl,bclhp->bchpn', bm, to_end, xd)
    chunk_decay = jnp.exp(a_cs[..., -1])

    def step(hc, inp):
        s_c, d_c = inp
        return hc * d_c[..., None, None] + s_c, hc

    h_final, h_in = lax.scan(step, h0, (jnp.moveaxis(st, 1, 0), jnp.moveaxis(chunk_decay, -1, 0)))
    y = y + jnp.einsum('bclhn,cbhpn,bhcl->bclhp', cm, h_in, jnp.exp(a_cs))
    return y.reshape(b, l, h, p), h_final


def ssd_mixer(z, xbc, dt_raw, conv_w, conv_b, dt_bias, a_log, d_skip, norm_g, h0):
    b, l, _ = z.shape
    xbc = jax.nn.silu(dwconv(xbc, conv_w) + conv_b).astype(jnp.float32)
    xs, bm, cm = jnp.split(xbc, [SSD_INNER, SSD_INNER + SSD_GROUPS * SSD_STATE], axis=-1)
    xs = xs.reshape(b, l, SSD_HEADS, SSD_HEADDIM)
    rep = SSD_HEADS // SSD_GROUPS
    bm = jnp.repeat(bm.reshape(b, l, SSD_GROUPS, SSD_STATE), rep, axis=2)
    cm = jnp.repeat(cm.reshape(b, l, SSD_GROUPS, SSD_STATE), rep, axis=2)
    dt = jax.nn.softplus(dt_raw.astype(jnp.float32).reshape(b, l, 2, SSD_HEADS) + dt_bias.astype(jnp.float32))
    a = -jnp.exp(a_log.astype(jnp.float32))
    h0 = h0.astype(jnp.float32)
    y_f, s_f = ssd_scan(xs, dt[:, :, 0], a[0], bm, cm, h0[:, 0])

    def flip(t):
        return jnp.flip(t, axis=1)

    y_b, s_b = ssd_scan(flip(xs), flip(dt[:, :, 1]), a[1], flip(bm), flip(cm), h0[:, 1])
    y = y_f + flip(y_b) + xs * jnp.sum(d_skip.astype(jnp.float32), axis=0)[:, None]
    y = y.reshape(b, l, SSD_INNER) * jax.nn.silu(z.astype(jnp.float32))
    y = rmsnorm(y, norm_g).astype(z.dtype)
    return y, jnp.stack([s_f, s_b], axis=1)


def mixer_ssd_conv(h, P, e, h0):
    u = h @ P['ssd_w_in'][e]
    s1 = SSD_INNER
    s2 = s1 + SSD_XBC
    s3 = s2 + 2 * SSD_HEADS
    s4 = s3 + SC_WIDTH
    s5 = s4 + SC_WIDTH
    z, xbc, dt_raw, bg, cg, xin = jnp.split(u, [s1, s2, s3, s4, s5], axis=-1)
    y_a, states = ssd_mixer(z, xbc, dt_raw, P['ssd_conv_w'][e], P['ssd_conv_b'][e], P['ssd_dt_bias'][e],
                            P['ssd_a_log'][e], P['ssd_d'][e], P['ssd_norm_g'][e], h0)
    y_b = bg * dwconv(cg * xin, P['sc_conv_w'][e])
    return jnp.concatenate([y_a, y_b], axis=-1) @ P['mix0_w_out'][e], states


def split_heads(t, b, l):
    return t.reshape(b, l, NA_HEADS, NA_HEAD_DIM)


def dense_context_attention(q, k, v):
    b, s, h, d = q.shape
    qb = jnp.moveaxis(q.reshape(b, s // Q_BLOCK, Q_BLOCK, h, d), 1, 0)

    def one_block(qi):
        sc = jnp.einsum('bqhd,bkhd->bhqk', qi, k).astype(jnp.float32) * (d ** -0.5)
        p = jax.nn.softmax(sc, axis=-1).astype(v.dtype)
        return jnp.einsum('bhqk,bkhd->bqhd', p, v)

    o = lax.map(one_block, qb)
    return jnp.moveaxis(o, 0, 1).reshape(b, s, h * d)


def na_context(h, P, o):
    b, s, _ = h.shape
    q, k, v = [split_heads(t, b, s) for t in jnp.split(h @ P['na_w_qkv'][o], 3, axis=-1)]
    y = dense_context_attention(q, k, v)
    return y @ P['na_w_out'][o], k, v


def na_latent(h, P, o, k_ctx, v_ctx):
    b, l, _ = h.shape
    rows = l // GRID_W
    kh = min(NA_KH, rows)
    nb = GRID_W // NA_KW
    span = 2 * NA_KW
    q, k, v = [split_heads(t, b, l) for t in jnp.split(h @ P['na_w_qkv'][o], 3, axis=-1)]
    r = np.arange(rows)
    row_idx = np.clip(r - kh // 2, 0, rows - kh)[:, None] + np.arange(kh)
    qcol = np.arange(GRID_W).reshape(nb, NA_KW)
    col_idx = np.clip(np.arange(nb) * NA_KW - NA_KW // 2, 0, GRID_W - span)[:, None] + np.arange(span)
    col_start = np.clip(qcol - NA_KW // 2, 0, GRID_W - NA_KW)
    col_ok = (col_idx[:, None, :] >= col_start[:, :, None]) & (col_idx[:, None, :] < col_start[:, :, None] + NA_KW)
    dr = row_idx - r[:, None] + NA_KH - 1
    dc = np.clip(col_idx[:, None, :] - qcol[:, :, None] + NA_KW - 1, 0, 2 * NA_KW - 2)
    rpb = P['na_rpb'][o].astype(jnp.float32)
    bias = rpb[:, dr[:, None, None, :, None], dc[None, :, :, None, :]]
    bias = jnp.where(col_ok[None, None, :, :, None, :], bias, -jnp.inf)
    bias = jnp.moveaxis(bias, 0, 2).reshape(rows, nb, NA_HEADS, NA_KW, kh * span)
    kg = k.reshape(b, rows, GRID_W, NA_HEADS, NA_HEAD_DIM)
    vg = v.reshape(b, rows, GRID_W, NA_HEADS, NA_HEAD_DIM)
    ri = row_idx[:, None, :, None]
    ci = col_idx[None, :, None, :]
    n_loc = kh * span
    k_loc = kg[:, ri, ci].reshape(b, rows, nb, n_loc, NA_HEADS, NA_HEAD_DIM)
    v_loc = vg[:, ri, ci].reshape(b, rows, nb, n_loc, NA_HEADS, NA_HEAD_DIM)
    qb = q.reshape(b, rows, nb, NA_KW, NA_HEADS, NA_HEAD_DIM)
    scale = NA_HEAD_DIM ** -0.5
    s_loc = jnp.einsum('brjqhd,brjkhd->brjhqk', qb, k_loc).astype(jnp.float32) * scale + bias
    s_ctx = jnp.einsum('brjqhd,bshd->brjhqs', qb, k_ctx).astype(jnp.float32) * scale
    p = jax.nn.softmax(jnp.concatenate([s_loc, s_ctx], axis=-1), axis=-1).astype(v.dtype)
    out = (jnp.einsum('brjhqk,brjkhd->brjqhd', p[..., :n_loc], v_loc)
           + jnp.einsum('brjhqs,bshd->brjqhd', p[..., n_loc:], v_ctx))
    return out.reshape(b, l, NA_INNER) @ P['na_w_out'][o]


def conv_ffn(h, P, i):
    g = dwconv(h @ P['ffn_w_gate'][i], P['ffn_conv_w'][i])
    u = h @ P['ffn_w_up'][i]
    return (jax.nn.gelu(g) * u) @ P['ffn_w_down'][i]


def run_stream(x, cvec, P, is_ctx, state_ssd, cache_k, cache_v):
    new_ssd, new_k, new_v = [], [], []
    b = x.shape[0]
    for i in range(DEPTH):
        m = jax.nn.silu(cvec) @ P['ada_w'][i] + P['ada_b'][i]
        sh1, sc1, g1, sh2, sc2, g2 = jnp.split(m[:, None, :].astype(x.dtype), N_MOD, axis=-1)
        h = rmsnorm(x, P['norm_mix_g'][i]) * (1 + sc1) + sh1
        if i % 2 == 0:
            e = i // 2
            if is_ctx:
                h0 = jnp.zeros((b, 2, SSD_HEADS, SSD_HEADDIM, SSD_STATE), jnp.float32)
            else:
                h0 = state_ssd[:, e]
            y, st = mixer_ssd_conv(h, P, e, h0)
            new_ssd.append(st.astype(x.dtype))
        else:
            o = i // 2
            if is_ctx:
                y, k, v = na_context(h, P, o)
                new_k.append(k)
                new_v.append(v)
            else:
                y = na_latent(h, P, o, cache_k[:, o], cache_v[:, o])
        x = x + g1 * y
        h = rmsnorm(x, P['norm_ffn_g'][i]) * (1 + sc2) + sh2
        x = x + g2 * conv_ffn(h, P, i)
    return rmsnorm(x, P['final_norm_g']), new_ssd, new_k, new_v


def setup_inputs(seed: int = 0) -> dict:
    key = jax.random.key(seed)
    ks = iter(jax.random.split(key, 40))

    def nrm(shape, s):
        return jax.random.normal(next(ks), shape, jnp.float32) * s

    dt0 = jnp.exp(jax.random.uniform(next(ks), (N_SSD_LAYERS, 2, SSD_HEADS), jnp.float32,
                                     np.log(1e-3), np.log(1e-1)))
    return {
        'x_prompt': nrm((BATCH, SEQ, D_MODEL), 1.0),
        'x_sample': nrm((DEC_BATCH, DEC_SEQ, D_MODEL), 1.0),
        'state_ssd': nrm((DEC_BATCH, N_SSD_LAYERS, 2, SSD_HEADS, SSD_HEADDIM, SSD_STATE), 0.5),
        'cache_k': nrm((DEC_BATCH, N_NA_LAYERS, PAST_LEN, NA_HEADS, NA_HEAD_DIM), 1.0),
        'cache_v': nrm((DEC_BATCH, N_NA_LAYERS, PAST_LEN, NA_HEADS, NA_HEAD_DIM), 1.0),
        'c': nrm((DEC_BATCH, D_MODEL), 1.0),
        'c_ctx': nrm((D_MODEL,), 1.0),
        'ada_w': nrm((DEPTH, D_MODEL, N_MOD * D_MODEL), 0.5 * D_MODEL ** -0.5),
        'ada_b': nrm((DEPTH, N_MOD * D_MODEL), 0.01),
        'norm_mix_g': 1.0 + nrm((DEPTH, D_MODEL), 0.02),
        'norm_ffn_g': 1.0 + nrm((DEPTH, D_MODEL), 0.02),
        'ssd_w_in': nrm((N_SSD_LAYERS, D_MODEL, MIX0_IN), D_MODEL ** -0.5),
        'ssd_conv_w': nrm((N_SSD_LAYERS, SSD_CONV_W, SSD_XBC), SSD_CONV_W ** -0.5),
        'ssd_conv_b': nrm((N_SSD_LAYERS, SSD_XBC), 0.01),
        'ssd_dt_bias': dt0 + jnp.log(-jnp.expm1(-dt0)),
        'ssd_a_log': jnp.log(jax.random.uniform(next(ks), (N_SSD_LAYERS, 2, SSD_HEADS), jnp.float32, 1.0, 16.0)),
        'ssd_d': 0.5 + nrm((N_SSD_LAYERS, 2, SSD_HEADS), 0.02),
        'ssd_norm_g': 1.0 + nrm((N_SSD_LAYERS, SSD_INNER), 0.02),
        'sc_conv_w': nrm((N_SSD_LAYERS, SC_CONV_W, SC_WIDTH), SC_CONV_W ** -0.5),
        'mix0_w_out': nrm((N_SSD_LAYERS, MIX0_OUT, D_MODEL), MIX0_OUT ** -0.5),
        'na_w_qkv': nrm((N_NA_LAYERS, D_MODEL, 3 * NA_INNER), D_MODEL ** -0.5),
        'na_rpb': nrm((N_NA_LAYERS, NA_HEADS, 2 * NA_KH - 1, 2 * NA_KW - 1), 0.02),
        'na_w_out': nrm((N_NA_LAYERS, NA_INNER, D_MODEL), NA_INNER ** -0.5),
        'ffn_w_gate': nrm((DEPTH, D_MODEL, D_FF), D_MODEL ** -0.5),
        'ffn_w_up': nrm((DEPTH, D_MODEL, D_FF), D_MODEL ** -0.5),
        'ffn_conv_w': nrm((DEPTH, FFN_CONV_W, D_FF), FFN_CONV_W ** -0.5),
        'ffn_w_down': nrm((DEPTH, D_FF, D_MODEL), D_FF ** -0.5),
        'final_norm_g': 1.0 + nrm((D_MODEL,), 0.02),
    }


def reference(x_prompt, x_sample, state_ssd, cache_k, cache_v, c, c_ctx, ada_w, ada_b, norm_mix_g, norm_ffn_g,
              ssd_w_in, ssd_conv_w, ssd_conv_b, ssd_dt_bias, ssd_a_log, ssd_d, ssd_norm_g, sc_conv_w, mix0_w_out,
              na_w_qkv, na_rpb, na_w_out, ffn_w_gate, ffn_w_up, ffn_conv_w, ffn_w_down, final_norm_g):
    P = {'ada_w': ada_w, 'ada_b': ada_b, 'norm_mix_g': norm_mix_g, 'norm_ffn_g': norm_ffn_g,
         'ssd_w_in': ssd_w_in, 'ssd_conv_w': ssd_conv_w, 'ssd_conv_b': ssd_conv_b, 'ssd_dt_bias': ssd_dt_bias,
         'ssd_a_log': ssd_a_log, 'ssd_d': ssd_d, 'ssd_norm_g': ssd_norm_g, 'sc_conv_w': sc_conv_w,
         'mix0_w_out': mix0_w_out, 'na_w_qkv': na_w_qkv, 'na_rpb': na_rpb, 'na_w_out': na_w_out,
         'ffn_w_gate': ffn_w_gate, 'ffn_w_up': ffn_w_up, 'ffn_conv_w': ffn_conv_w, 'ffn_w_down': ffn_w_down,
         'final_norm_g': final_norm_g}
    y_prompt, ssd_list, k_list, v_list = run_stream(x_prompt, c_ctx[None, :], P, True, None, None, None)
    new_state_ssd = jnp.stack(ssd_list, axis=1)
    new_cache_k = jnp.stack(k_list, axis=1)
    new_cache_v = jnp.stack(v_list, axis=1)
    y_sample, _, _, _ = run_stream(x_sample, c, P, False, state_ssd, cache_k, cache_v)
    return (y_prompt, y_sample, new_state_ssd, new_cache_k, new_cache_v)
```

```cpp
#include <hip/hip_runtime.h>
#include <hip/hip_cooperative_groups.h>
#include <cstdio>
#include <cstdint>
namespace cg = cooperative_groups;

#define LAS __attribute__((address_space(3)))
typedef unsigned short bf16_t;
typedef short bf16x8 __attribute__((ext_vector_type(8)));
typedef float f32x4 __attribute__((ext_vector_type(4)));
typedef float f32x2 __attribute__((ext_vector_type(2)));
typedef unsigned u32x4 __attribute__((ext_vector_type(4)));
typedef unsigned u32x2 __attribute__((ext_vector_type(2)));

constexpr int D = 1024, T_CTX = 8192, T_LAT = 2048, T = 10240;
constexpr int NIN_SRC = 5664, NIN = 5888, NGU = 5632, DFF = 2816, NQKV = 3072;
constexpr int NTHREADS = 512, NWAVES = 8;
constexpr int LDS_BYTES = 147456;

constexpr size_t WS_BAR = 0;
constexpr size_t WS_MOD = 16384;
constexpr size_t WS_WIN = 262144;
constexpr size_t WS_WMO = WS_WIN + (size_t)NIN * 1024 * 2;
constexpr size_t WS_WGU0 = WS_WMO + (size_t)1024 * 2048 * 2;
constexpr size_t WS_WGU1 = WS_WGU0 + (size_t)NGU * 1024 * 2;
constexpr size_t WS_WDN0 = WS_WGU1 + (size_t)NGU * 1024 * 2;
constexpr size_t WS_WDN1 = WS_WDN0 + (size_t)1024 * DFF * 2;
constexpr size_t WS_WQKV = WS_WDN1 + (size_t)1024 * DFF * 2;
constexpr size_t WS_WNAO = WS_WQKV + (size_t)NQKV * 1024 * 2;
constexpr size_t WS_R1 = 62914560;
static_assert(WS_WNAO + (size_t)1024 * 1024 * 2 <= WS_R1, "weights overflow");
constexpr size_t WS_Z = WS_R1;
constexpr size_t WS_XR = WS_Z + (size_t)T * 1024 * 2;
constexpr size_t WS_BCX = WS_XR + (size_t)T * 1536 * 2;
constexpr size_t WS_GU = WS_R1;
constexpr size_t WS_QKV = WS_R1;
constexpr size_t WS_YB = WS_XR;
constexpr size_t WS_YPART = WS_XR + (size_t)T * 1024 * 4;
static_assert(WS_YPART + (size_t)T * 1024 * 4 <= WS_BCX + (size_t)T * 3072 * 2, "SSD partials overflow R1");
constexpr size_t WS_R2 = WS_R1 + (size_t)T * 5632 * 2;
constexpr size_t WS_XC = WS_R2;
constexpr size_t WS_YCAT = WS_XC + (size_t)T * 1536 * 2;
constexpr size_t WS_H = WS_R2;
constexpr size_t WS_ACT = WS_R1;
constexpr size_t WS_ATT = WS_R2;
constexpr size_t WS_DTRAW = WS_YCAT + (size_t)T * 2048 * 2;
constexpr size_t WS_DT = WS_DTRAW + (size_t)T * 32 * 4;
constexpr size_t WS_HALO = WS_DT + (size_t)T * 32 * 4;
constexpr size_t WS_END = WS_HALO + (size_t)12 * 2816 * 4;
static_assert(WS_END <= 268435456ull, "workspace over 256 MiB");

constexpr size_t OUT_Y = 0, OUT_STATE = 10485760, OUT_K = 18874368, OUT_V = 27262976;

__device__ __forceinline__ unsigned f2bf(float f) { unsigned u = __builtin_bit_cast(unsigned, f); return (u + 0x7fffu + ((u >> 16) & 1u)) >> 16; }
__device__ __forceinline__ unsigned pk2(float lo, float hi) { unsigned r; asm("v_cvt_pk_bf16_f32 %0, %1, %2" : "=v"(r) : "v"(lo), "v"(hi)); return r; }
__device__ __forceinline__ float bflo(unsigned w) { return __builtin_bit_cast(float, w << 16); }
__device__ __forceinline__ float bfhi(unsigned w) { return __builtin_bit_cast(float, w & 0xffff0000u); }
__device__ __forceinline__ float bf1(bf16_t h) { return __builtin_bit_cast(float, ((unsigned)h) << 16); }
__device__ __forceinline__ float wave_sum(float v) {
#pragma unroll
    for (int o = 1; o < 64; o <<= 1) v += __shfl_xor(v, o);
    return v;
}
__device__ __forceinline__ float silu_f(float x) { return x * __builtin_amdgcn_rcpf(1.f + __builtin_amdgcn_exp2f(-1.4426950409f * x)); }
__device__ __forceinline__ float gelu_fast(float x) { const float t = x * (1.5957691216f + 0.0713548163f * x * x); return x * __builtin_amdgcn_rcpf(1.f + __builtin_amdgcn_exp2f(-1.4426950409f * t)); }
__device__ __forceinline__ float gelu_tanh_f(float x) {
    const float u = 0.7978845608028654f * (x + 0.044715f * x * x * x);
    const float e = __expf(-2.f * fabsf(u)); float th = (1.f - e) / (1.f + e); th = u < 0.f ? -th : th;
    return 0.5f * x * (1.f + th);
}
#define LDS_BARRIER() do { asm volatile("s_waitcnt lgkmcnt(0)" ::: "memory"); __builtin_amdgcn_s_barrier(); asm volatile("" ::: "memory"); } while (0)
#define MFMA16(a, b, c) __builtin_amdgcn_mfma_f32_16x16x32_bf16((a), (b), (c), 0, 0, 0)

namespace pg8 {
constexpr int BM = 256, BK = 64, HALF = 128, HTB = HALF * BK * 2, STAGE_BYTES = 8 * HTB, NXCD = 8, WGM = 8;
__host__ __device__ __forceinline__ int lds_byte(int r, int c) { const int st = (r >> 4) * 2 + (c >> 5), rr = r & 15, cc = c & 31, ob = rr * 64 + cc * 2; return st * 1024 + (ob ^ (((ob >> 9) & 1) << 5)); }
__host__ __device__ __forceinline__ void stage_rc(int b, int& R, int& C) { const int st = b / 1024, sb = b % 1024, swz = sb ^ (((sb >> 9) & 1) << 5); R = (st >> 1) * 16 + swz / 64; C = (st & 1) * 32 + (swz % 64) / 2; }
__host__ __device__ __forceinline__ int perm32(int rho) { const int n = rho >> 4, i = rho & 15; return 8 * (i >> 2) + 4 * n + (i & 3); }
struct Unit { int pm, pn; };
struct Gemm { const bf16_t* A; const bf16_t* Bt; int M, N, K; };
struct StaticOrder {
    int nM, nN, nwg, G, c, wgm;
    __device__ void init(int M, int N, int G_, int c_) { nM = M / BM; nN = N / BM; nwg = nM * nN; G = G_; c = c_; wgm = (nN == 4) ? 5 : WGM; }
    __device__ bool next(int i, Unit& u) const {
        const long L = (long)i * G + c; if (L >= nwg) return false;
        int wgid = (int)L; { const int q = nwg / NXCD, r = nwg % NXCD, xcd = wgid % NXCD, off = wgid / NXCD; wgid = (xcd < r ? xcd * (q + 1) : r * (q + 1) + (xcd - r) * q) + off; }
        const int nig = wgm * nN, gid = wgid / nig, fm = gid * wgm, gsz = (nM - fm) < wgm ? (nM - fm) : wgm;
        u.pm = fm + ((wgid % nig) % gsz); u.pn = (wgid % nig) / gsz; return true;
    }
};
__device__ __forceinline__ unsigned cvt_pk_bf16(float lo, float hi) { unsigned r; asm volatile("v_cvt_pk_bf16_f32 %0, %1, %2" : "=v"(r) : "v"(lo), "v"(hi)); return r; }

__device__ __forceinline__ void store_bf16_tile(const f32x4 (&acc)[2][2][4][2], bf16_t* base, int ldc, int row0, int col0) {
#pragma unroll
    for (int ai = 0; ai < 2; ++ai)
#pragma unroll
        for (int m = 0; m < 4; ++m) { bf16_t* rowp = base + (size_t)(row0 + ai * HALF + m * 16) * ldc + col0;
#pragma unroll
            for (int bj = 0; bj < 2; ++bj) { const f32x4 v0 = acc[ai][bj][m][0], v1 = acc[ai][bj][m][1];
                u32x4 w; w.x = cvt_pk_bf16(v0[0], v0[1]); w.y = cvt_pk_bf16(v0[2], v0[3]); w.z = cvt_pk_bf16(v1[0], v1[1]); w.w = cvt_pk_bf16(v1[2], v1[3]);
                *(u32x4*)(rowp + bj * HALF) = w; } }
}
struct EpiIn {
    static constexpr bool PERM = true, ALIGN = false;
    bf16_t* Z; bf16_t* XR; bf16_t* BCX; float* DTRAW;
    __device__ __forceinline__ void operator()(const f32x4 (&acc)[2][2][4][2], const Unit& u, int wr, int wc, int fr, int fq) const {
        const int row0 = u.pm * BM + wr * 64 + fr;
        if (u.pn == 22) {
            if (wc == 0) {
#pragma unroll
                for (int ai = 0; ai < 2; ++ai)
#pragma unroll
                    for (int m = 0; m < 4; ++m) { float* p = DTRAW + (size_t)(row0 + ai * HALF + m * 16) * 32 + 8 * fq;
                        *(f32x4*)p = acc[ai][0][m][0]; *(f32x4*)(p + 4) = acc[ai][0][m][1]; }
            }
            return;
        }
        bf16_t* base; int ldc, colt;
        if (u.pn < 4) { base = Z; ldc = 1024; colt = u.pn * 256; } else if (u.pn < 10) { base = XR; ldc = 1536; colt = (u.pn - 4) * 256; } else { base = BCX; ldc = 3072; colt = (u.pn - 10) * 256; }
        store_bf16_tile(acc, base, ldc, row0, colt + wc * 32 + 8 * fq);
    }
};
struct EpiBf {
    static constexpr bool PERM = true, ALIGN = false;
    bf16_t* O; int ldc;
    __device__ __forceinline__ void operator()(const f32x4 (&acc)[2][2][4][2], const Unit& u, int wr, int wc, int fr, int fq) const {
        store_bf16_tile(acc, O, ldc, u.pm * BM + wr * 64 + fr, u.pn * BM + wc * 32 + 8 * fq);
    }
};
struct EpiQKV {
    static constexpr bool PERM = true, ALIGN = false;
    bf16_t* O; float* OK; float* OV;
    __device__ __forceinline__ void operator()(const f32x4 (&acc)[2][2][4][2], const Unit& u, int wr, int wc, int fr, int fq) const {
        const int row0 = u.pm * BM + wr * 64 + fr, col0 = u.pn * BM + wc * 32 + 8 * fq;
        store_bf16_tile(acc, O, NQKV, row0, col0);
        if (u.pm < 32 && u.pn >= 4) {
            float* base = (u.pn < 8) ? (OK + (col0 - 1024)) : (OV + (col0 - 2048));
#pragma unroll
            for (int ai = 0; ai < 2; ++ai)
#pragma unroll
                for (int m = 0; m < 4; ++m) { float* rowp = base + (size_t)(row0 + ai * HALF + m * 16) * 1024;
#pragma unroll
                    for (int bj = 0; bj < 2; ++bj) { *(f32x4*)(rowp + bj * HALF) = acc[ai][bj][m][0]; *(f32x4*)(rowp + bj * HALF + 4) = acc[ai][bj][m][1]; } }
        }
    }
};
struct EpiRes {
    static constexpr bool PERM = false, ALIGN = false;
    const float* base_lo; const float* base_hi; float* out; const float* gate;
    __device__ __forceinline__ void operator()(const f32x4 (&acc)[2][2][4][2], const Unit& u, int wr, int wc, int fr, int fq) const {
        const int row0 = u.pm * BM + wr * 64 + fr, col0 = u.pn * BM + wc * 32 + 4 * fq;
        const int v = u.pm < 32 ? 0 : 1 + ((u.pm - 32) >> 2);
        const float* gv = gate + v * 6144 + col0;
        f32x4 g[2][2];
#pragma unroll
        for (int bj = 0; bj < 2; ++bj)
#pragma unroll
            for (int n = 0; n < 2; ++n) g[bj][n] = *(const f32x4*)(gv + bj * HALF + n * 16);
        const float* base = u.pm < 32 ? base_lo : base_hi;
        f32x4 bb[2][2][2][2];
#define EPIRES_LOAD(buf, gi) do { _Pragma("unroll") for (int mm = 0; mm < 2; ++mm) { const size_t off_ = (size_t)(row0 + ((gi) >> 1) * HALF + (2 * ((gi) & 1) + mm) * 16) * 1024 + col0; \
            _Pragma("unroll") for (int bj = 0; bj < 2; ++bj) _Pragma("unroll") for (int n = 0; n < 2; ++n) bb[buf][mm][bj][n] = *(const f32x4*)(base + off_ + bj * HALF + n * 16); } } while (0)
        EPIRES_LOAD(0, 0);
#pragma unroll
        for (int gi = 0; gi < 4; ++gi) {
            if (gi < 3) EPIRES_LOAD((gi + 1) & 1, gi + 1);
#pragma unroll
            for (int mm = 0; mm < 2; ++mm) { const int ai = gi >> 1, m = 2 * (gi & 1) + mm; const size_t off = (size_t)(row0 + ai * HALF + m * 16) * 1024 + col0;
#pragma unroll
                for (int bj = 0; bj < 2; ++bj)
#pragma unroll
                    for (int n = 0; n < 2; ++n) *(f32x4*)(out + off + bj * HALF + n * 16) = bb[gi & 1][mm][bj][n] + g[bj][n] * acc[ai][bj][m][n]; }
        }
#undef EPIRES_LOAD
    }
};

__device__ __forceinline__ f32x4 dpp_ror1(f32x4 v) { f32x4 r;
#pragma unroll
    for (int e = 0; e < 4; ++e) { const float x = v[e]; r[e] = __int_as_float(__builtin_amdgcn_update_dpp(0, __float_as_int(x), 0x121, 0xf, 0xf, false)); }
    return r; }
__device__ __forceinline__ f32x4 dpp_ror15(f32x4 v) { f32x4 r;
#pragma unroll
    for (int e = 0; e < 4; ++e) { const float x = v[e]; r[e] = __int_as_float(__builtin_amdgcn_update_dpp(0, __float_as_int(x), 0x12f, 0xf, 0xf, false)); }
    return r; }
struct EpiGUF {
    static constexpr bool PERM = true, ALIGN = true;
    bf16_t* ACTp; const float* fw; const float* HALO; LAS float* X;
    __device__ __forceinline__ void operator()(const f32x4 (&acc)[2][2][4][2], const Unit& u, int wr, int wc, int fr, int fq) const {
        const int cl = wc * 32 + 8 * fq;
        const int gc0 = u.pn * 128 + cl;
        f32x4 w0[2], w1[2], w2[2];
#pragma unroll
        for (int n = 0; n < 2; ++n) { w0[n] = *(const f32x4*)(fw + gc0 + 4 * n); w1[n] = *(const f32x4*)(fw + DFF + gc0 + 4 * n); w2[n] = *(const f32x4*)(fw + 2 * DFF + gc0 + 4 * n); }
        f32x4 hu[2], hd[2];
        {
            const f32x4 z = {0.f, 0.f, 0.f, 0.f};
            const bool lat = u.pm >= 32; const int q = (u.pm - 32) & 3, sq = (u.pm - 32) >> 2;
            const bool hasu = lat && q > 0, hasd = lat && q < 3;
            const float* pu = HALO + (size_t)(sq * 6 + 2 * (q - 1)) * DFF + gc0; const float* pd = HALO + (size_t)(sq * 6 + 2 * q + 1) * DFF + gc0;
#pragma unroll
            for (int n = 0; n < 2; ++n) { hu[n] = hasu ? *(const f32x4*)(pu + 4 * n) : z; hd[n] = hasd ? *(const f32x4*)(pd + 4 * n) : z; }
        }
#pragma unroll
        for (int ai = 0; ai < 2; ++ai) { const int rb = 2 * ai + wr;
            if (fr == 0) {
#pragma unroll
                for (int n = 0; n < 2; ++n) *(LAS f32x4*)(X + (rb * 2 + 0) * 128 + cl + 4 * n) = acc[ai][0][0][n]; }
            if (fr == 15) {
#pragma unroll
                for (int n = 0; n < 2; ++n) *(LAS f32x4*)(X + (rb * 2 + 1) * 128 + cl + 4 * n) = acc[ai][0][3][n]; } }
        asm volatile("s_waitcnt lgkmcnt(0)" ::: "memory"); __builtin_amdgcn_s_barrier(); asm volatile("" ::: "memory");
#pragma unroll
        for (int ai = 0; ai < 2; ++ai) { const int rb = 2 * ai + wr;
            f32x4 ux[2], dx[2];
#pragma unroll
            for (int n = 0; n < 2; ++n) {
                ux[n] = rb > 0 ? *(const LAS f32x4*)(X + ((rb - 1) * 2 + 1) * 128 + cl + 4 * n) : hu[n];
                dx[n] = rb < 3 ? *(const LAS f32x4*)(X + ((rb + 1) * 2 + 0) * 128 + cl + 4 * n) : hd[n]; }
#pragma unroll
            for (int m = 0; m < 4; ++m) {
                u32x4 o;
#pragma unroll
                for (int n = 0; n < 2; ++n) {
                    const f32x4 g = acc[ai][0][m][n];
                    const f32x4 tu = dpp_ror1(g), td = dpp_ror15(g);
                    f32x4 eu, ed;
                    if (m > 0) eu = dpp_ror1(acc[ai][0][m > 0 ? m - 1 : 0][n]); else eu = ux[n];
                    if (m < 3) ed = dpp_ror15(acc[ai][0][m < 3 ? m + 1 : 3][n]); else ed = dx[n];
                    f32x4 a;
#pragma unroll
                    for (int e = 0; e < 4; ++e) { const float up = fr > 0 ? tu[e] : eu[e], dn = fr < 15 ? td[e] : ed[e];
                        a[e] = gelu_fast(w0[n][e] * up + w1[n][e] * g[e] + w2[n][e] * dn) * acc[ai][1][m][n][e]; }
                    if (n == 0) { o.x = cvt_pk_bf16(a[0], a[1]); o.y = cvt_pk_bf16(a[2], a[3]); } else { o.z = cvt_pk_bf16(a[0], a[1]); o.w = cvt_pk_bf16(a[2], a[3]); }
                }
                *(u32x4*)(ACTp + (size_t)(u.pm * BM + ai * HALF + wr * 64 + m * 16 + fr) * DFF + gc0) = o;
            }
        }
    }
};

template <class Epi>
__device__ __forceinline__ void gemm_phase(LAS unsigned char* lds, const Gemm g, const StaticOrder& S, const Epi& E) {
    int tid_ = threadIdx.x; asm volatile("" : "+v"(tid_));
    const int tid = tid_, wid = __builtin_amdgcn_readfirstlane(tid >> 6), lane = tid & 63, wr = wid >> 2, wc = wid & 3, fr = lane & 15, fq = lane >> 4;
    const int K = g.K, nt = K / BK;
    unsigned voffA[2], voffB[2];
#pragma unroll
    for (int i = 0; i < 2; ++i) { int R, C; stage_rc(tid * 16 + i * 8192, R, C); const int Rb = Epi::PERM ? ((R & ~31) + perm32(R & 31)) : R;
        voffA[i] = (unsigned)(R * K + C) * 2u; voffB[i] = (unsigned)(Rb * K + C) * 2u; }
    const size_t kstep = (size_t)(BK * 2);
    const size_t hstep = (size_t)HALF * K * 2;
    const size_t tstep = 2 * hstep;
    const unsigned ldsw = (unsigned)wid * 1024u;
    const int aoff = lds_byte(wr * 64 + fr, fq * 8), boff = lds_byte(wc * 32 + fr, fq * 8);
#define PG8_SA(b, h) (((b) * 2 + (h)) * HTB)
#define PG8_SB(b, h) ((4 + (b) * 2 + (h)) * HTB)
#define PG8_STAGE(bufoff, gbase, voff) do { _Pragma("unroll") for (int _i = 0; _i < 2; ++_i) \
        __builtin_amdgcn_global_load_lds((const unsigned*)((const char*)(gbase) + (voff)[_i]), (LAS unsigned*)(lds + (bufoff) + ldsw + _i * 8192), 16, 0, 0); } while (0)
#define PG8_LDA(dst, b, h) do { _Pragma("unroll") for (int m = 0; m < 4; ++m) _Pragma("unroll") for (int k = 0; k < 2; ++k) dst[m][k] = *(const LAS bf16x8*)(lds + PG8_SA(b, h) + aoff + m * 2048 + k * 1024); } while (0)
#define PG8_LDB(dst, b, h) do { _Pragma("unroll") for (int n = 0; n < 2; ++n) _Pragma("unroll") for (int k = 0; k < 2; ++k) dst[n][k] = *(const LAS bf16x8*)(lds + PG8_SB(b, h) + boff + n * 2048 + k * 1024); } while (0)
#define PG8_MMA(ai, bj, At, Bt) do { __builtin_amdgcn_s_setprio(1); _Pragma("unroll") for (int m = 0; m < 4; ++m) _Pragma("unroll") for (int n = 0; n < 2; ++n) _Pragma("unroll") for (int k = 0; k < 2; ++k) \
        acc[ai][bj][m][n] = __builtin_amdgcn_mfma_f32_16x16x32_bf16(Bt[n][k], At[m][k], acc[ai][bj][m][n], 0, 0, 0); __builtin_amdgcn_s_setprio(0); } while (0)
#define PG8_WAIT_V(n) asm volatile("s_waitcnt vmcnt(" #n ")" ::: "memory")
#define PG8_WAIT_L(n) asm volatile("s_waitcnt lgkmcnt(" #n ")" ::: "memory")
#define PG8_BAR __builtin_amdgcn_s_barrier()
#define PG8_SCHED __builtin_amdgcn_sched_barrier(0)
    Unit cur, nxt; int ui = 0;
    if (!S.next(0, cur)) return;
    if (S.nwg > S.G) {
        const int rounds = (S.nwg + S.G - 1) / S.G;
        if ((long)(rounds - 1) * S.G + S.c >= S.nwg) { for (int i = 0; i < 3; ++i) __builtin_amdgcn_s_sleep(127); }
    }
    f32x4 acc[2][2][4][2];
#pragma unroll
    for (int a = 0; a < 2; ++a)
#pragma unroll
        for (int b = 0; b < 2; ++b)
#pragma unroll
            for (int m = 0; m < 4; ++m)
#pragma unroll
                for (int n = 0; n < 2; ++n) acc[a][b][m][n] = (f32x4){0.f, 0.f, 0.f, 0.f};
    bf16x8 At[4][2], B0[2][2], B1[2][2];
    const char* cA = (const char*)g.A + (size_t)cur.pm * tstep; const char* cB = (const char*)g.Bt + (size_t)cur.pn * tstep;
    PG8_STAGE(PG8_SB(0, 0), cB, voffB); PG8_STAGE(PG8_SA(0, 0), cA, voffA); PG8_STAGE(PG8_SB(0, 1), cB + hstep, voffB); PG8_STAGE(PG8_SA(0, 1), cA + hstep, voffA);
    if (wr == 1) PG8_BAR;
    PG8_WAIT_V(4); PG8_BAR;
    PG8_STAGE(PG8_SB(1, 0), cB + kstep, voffB); PG8_STAGE(PG8_SA(1, 0), cA + kstep, voffA); PG8_STAGE(PG8_SB(1, 1), cB + hstep + kstep, voffB);
    PG8_WAIT_V(6); PG8_BAR;
    for (;;) {
        const bool has_next = S.next(ui + 1, nxt);
        const char* nA = has_next ? (const char*)g.A + (size_t)nxt.pm * tstep : cA; const char* nB = has_next ? (const char*)g.Bt + (size_t)nxt.pn * tstep : cB;
        for (int t = 0; t < nt; t += 2) {
            const bool last = (t == nt - 2);
            const char* a1 = cA + (size_t)(t + 1) * kstep;
            const char* a2 = last ? nA : cA + (size_t)(t + 2) * kstep; const char* b2 = last ? nB : cB + (size_t)(t + 2) * kstep;
            const char* a3 = a2 + kstep; const char* b3 = b2 + kstep;
            PG8_LDB(B0, 0, 0); PG8_SCHED; PG8_LDA(At, 0, 0); PG8_STAGE(PG8_SA(1, 1), a1 + hstep, voffA);
            PG8_WAIT_L(8); PG8_BAR; PG8_WAIT_L(0); PG8_MMA(0, 0, At, B0); PG8_BAR; PG8_SCHED;
            PG8_LDB(B1, 0, 1); PG8_STAGE(PG8_SB(0, 0), b2, voffB);
            PG8_BAR; PG8_WAIT_L(0); PG8_MMA(0, 1, At, B1); PG8_BAR;
            PG8_LDA(At, 0, 1); PG8_STAGE(PG8_SA(0, 0), a2, voffA);
            PG8_BAR; PG8_WAIT_L(0); PG8_MMA(1, 0, At, B0); PG8_BAR; PG8_SCHED;
            PG8_STAGE(PG8_SB(0, 1), b2 + hstep, voffB);
            PG8_WAIT_V(6); PG8_BAR; PG8_MMA(1, 1, At, B1); PG8_BAR;
            PG8_LDB(B0, 1, 0); PG8_SCHED; PG8_LDA(At, 1, 0); PG8_STAGE(PG8_SA(0, 1), a2 + hstep, voffA);
            PG8_WAIT_L(8); PG8_BAR; PG8_WAIT_L(0); PG8_MMA(0, 0, At, B0); PG8_BAR; PG8_SCHED;
            PG8_LDB(B1, 1, 1); PG8_STAGE(PG8_SB(1, 0), b3, voffB);
            PG8_BAR; PG8_WAIT_L(0); PG8_MMA(0, 1, At, B1); PG8_BAR;
            PG8_LDA(At, 1, 1); PG8_STAGE(PG8_SA(1, 0), a3, voffA);
            PG8_BAR; PG8_WAIT_L(0); PG8_MMA(1, 0, At, B0); PG8_BAR; PG8_SCHED;
            PG8_STAGE(PG8_SB(1, 1), b3 + hstep, voffB);
            PG8_WAIT_V(6); PG8_BAR; PG8_MMA(1, 1, At, B1); PG8_BAR;
        }
        if constexpr (Epi::ALIGN) { if (wr == 0) PG8_BAR; }
        E(acc, cur, wr, wc, fr, fq);
        if (!has_next) break;
#pragma unroll
        for (int a = 0; a < 2; ++a)
#pragma unroll
            for (int b = 0; b < 2; ++b)
#pragma unroll
                for (int m = 0; m < 4; ++m)
#pragma unroll
                    for (int n = 0; n < 2; ++n) acc[a][b][m][n] = (f32x4){0.f, 0.f, 0.f, 0.f};
        cur = nxt; cA = nA; cB = nB; ++ui;
        if constexpr (Epi::ALIGN) { if (wr == 1) PG8_BAR; }
    }
    PG8_WAIT_V(0);
    if constexpr (!Epi::ALIGN) { if (wr == 0) PG8_BAR; }
    PG8_BAR;
#undef PG8_SA
#undef PG8_SB
#undef PG8_STAGE
#undef PG8_LDA
#undef PG8_LDB
#undef PG8_MMA
#undef PG8_WAIT_V
#undef PG8_WAIT_L
#undef PG8_BAR
#undef PG8_SCHED
}
}

__device__ __forceinline__ void norm_rows(int r0, int r1, const float* x_lo_, const float* x_hi_, const float* g, const float* modv, int sh_off, bf16_t* O, float* Of, int lane) {
    int curv = -1; f32x4 gs[4], shv[4], nx[4];
#pragma unroll
    for (int j = 0; j < 4; ++j) nx[j] = (f32x4){0.f, 0.f, 0.f, 0.f};
    if (r0 < r1) { const f32x4* xn = (const f32x4*)((r0 < T_CTX ? x_lo_ : x_hi_) + (size_t)r0 * 1024) + lane;
#pragma unroll
        for (int j = 0; j < 4; ++j) nx[j] = xn[64 * j]; }
    for (int m = r0; m < r1; ++m) {
        const int v = m < T_CTX ? 0 : 1 + ((m - T_CTX) >> 10);
        if (v != curv) { curv = v;
#pragma unroll
            for (int j = 0; j < 4; ++j) { const f32x4 gg = ((const f32x4*)g)[lane + 64 * j];
                if (modv) { const f32x4 a = ((const f32x4*)(modv + v * 6144 + sh_off + 1024))[lane + 64 * j]; gs[j] = gg * (a + 1.f); shv[j] = ((const f32x4*)(modv + v * 6144 + sh_off))[lane + 64 * j]; }
                else { gs[j] = gg; shv[j] = (f32x4){0.f, 0.f, 0.f, 0.f}; } } }
        f32x4 vv[4]; float s = 0.f;
#pragma unroll
        for (int j = 0; j < 4; ++j) { vv[j] = nx[j]; s += (vv[j].x * vv[j].x + vv[j].y * vv[j].y) + (vv[j].z * vv[j].z + vv[j].w * vv[j].w); }
        if (m + 1 < r1) { const f32x4* xn = (const f32x4*)((m + 1 < T_CTX ? x_lo_ : x_hi_) + (size_t)(m + 1) * 1024) + lane;
#pragma unroll
            for (int j = 0; j < 4; ++j) nx[j] = xn[64 * j]; }
        const float rstd = 1.f / sqrtf(wave_sum(s) * (1.f / 1024.f) + 1e-6f);
#pragma unroll
        for (int j = 0; j < 4; ++j) { const f32x4 y = vv[j] * rstd * gs[j] + shv[j];
            if (modv) { u32x2 wv; wv.x = pk2(y.x, y.y); wv.y = pk2(y.z, y.w); ((u32x2*)(O + (size_t)m * 1024))[lane + 64 * j] = wv; }
            else ((f32x4*)(Of + (size_t)m * 1024))[lane + 64 * j] = y; }
    }
}

#define XB_TMO      128
#define XB_XCNT(j)  (256  + 64 * (j))
#define XB_XSUB(j)  (1280 + 64 * (j))
#define XB_XGEN(j)  (2304 + 64 * (j))
#define XB_TOP      3328
#define XB_TOPGEN   3392
#define XCD_BAR_WORDS 3456
#define XB_SPIN_CAP (1u << 18)
__device__ __forceinline__ unsigned xb_ld(unsigned* p)              { return __hip_atomic_load(p, __ATOMIC_RELAXED, __HIP_MEMORY_SCOPE_AGENT); }
__device__ __forceinline__ unsigned xb_add(unsigned* p, unsigned v) { return __hip_atomic_fetch_add(p, v, __ATOMIC_RELAXED, __HIP_MEMORY_SCOPE_AGENT); }
__device__ __forceinline__ unsigned xb_xcc_id() { return (unsigned)__builtin_amdgcn_s_getreg((3 << 11) | 20) & 0xFu; }
#define XB_SPIN(cond, bar) do { unsigned _sp = 0; while (cond) { __builtin_amdgcn_s_sleep(1); \
    if ((++_sp & 255u) == 0u) { if (xb_ld(&(bar)[XB_TMO])) break; if (_sp > XB_SPIN_CAP) { atomicAdd(&(bar)[XB_TMO], 1u); break; } } } } while (0)
__device__ __forceinline__ void xcd_barrier_complete(unsigned* bar, unsigned x, unsigned& nloc, unsigned& nx) {
    const unsigned G = gridDim.x * gridDim.y * gridDim.z;
    unsigned sum, cnt, mine, sp = 0u;
    for (;;) {
        sum = 0u; cnt = 0u; mine = 0u;
#pragma unroll
        for (unsigned j = 0; j < 16; ++j) { const unsigned c = xb_ld(&bar[XB_XCNT(j)]); sum += c; cnt += (c > 0u) ? 1u : 0u; mine = (j == x) ? c : mine; }
        if (sum == G) break;
        __builtin_amdgcn_s_sleep(1);
        if ((++sp & 255u) == 0u) { if (xb_ld(&bar[XB_TMO])) break; if (sp > XB_SPIN_CAP) { atomicAdd(&bar[XB_TMO], 1u); break; } }
    }
    nloc = mine > 0u ? mine : 1u; nx = cnt > 0u ? cnt : 1u;
}
__device__ __forceinline__ void xcd_barrier(unsigned* bar, volatile LAS unsigned* st) {
    asm volatile("s_waitcnt vmcnt(0)" ::: "memory");
    __syncthreads();
    if (threadIdx.x == 0) {
        const unsigned x = xb_xcc_id();
        __builtin_amdgcn_s_waitcnt(0);
        unsigned nloc = st[0], nx = st[1];
        if (nloc == 0u) { xcd_barrier_complete(bar, x, nloc, nx); st[0] = nloc; st[1] = nx; }
        const unsigned old = xb_add(&bar[XB_XSUB(x)], 1u);
        const unsigned gen = old / nloc;
        if (old + 1u == (gen + 1u) * nloc) {
            __builtin_amdgcn_fence(__ATOMIC_RELEASE, "agent");
            asm volatile("s_waitcnt vmcnt(0)" ::: "memory");
            const unsigned og = xb_add(&bar[XB_TOP], 1u);
            const unsigned tg = og / nx;
            if (og + 1u == (tg + 1u) * nx) xb_add(&bar[XB_TOPGEN], 1u);
            else XB_SPIN(xb_ld(&bar[XB_TOPGEN]) == tg, bar);
            __builtin_amdgcn_fence(__ATOMIC_ACQUIRE, "agent");
            xb_add(&bar[XB_XGEN(x)], 1u);
            asm volatile("s_waitcnt vmcnt(0)" ::: "memory");
        } else {
            XB_SPIN(xb_ld(&bar[XB_XGEN(x)]) == gen, bar);
            __builtin_amdgcn_fence(__ATOMIC_ACQUIRE, "agent");
            asm volatile("s_waitcnt vmcnt(0)" ::: "memory");
        }
    }
    __syncthreads();
}

struct Args {
    const float* in[28];
    float* out; unsigned char* ws;
    int ph_lo, ph_hi;
};
enum { I_XP = 0, I_XS, I_STATE, I_CK, I_CV, I_C, I_CCTX, I_ADAW, I_ADAB, I_NMG, I_NFG, I_WIN, I_CONVW, I_CONVB, I_DTB, I_ALOG, I_DSK, I_SNG, I_SCW, I_WMO,
       I_WQKV, I_RPB, I_WNAO, I_WG, I_WU, I_FCW, I_WD, I_FNG };

__device__ __forceinline__ void transpose_item(const float* W, int K, int N, bf16_t* WT, int kind, LAS float* scr, int item, int lane) {
    const int nblk = N / 32, kb = item / nblk, nb = item % nblk, k0 = 64 * kb, n0 = 32 * nb;
    int r0;
    if (kind == 0) r0 = n0;
    else if (kind == 1) r0 = n0 < 2560 ? n0 : (n0 < 2592 ? n0 + 3072 : n0 - 32);
    else if (kind == 2) r0 = 256 * (n0 >> 7) + (n0 & 127);
    else r0 = 256 * (n0 >> 7) + 128 + (n0 & 127);
#pragma unroll 8
    for (int i = 0; i < 32; ++i) { const int kk = 2 * i + (lane >> 5); scr[kk * 33 + (lane & 31)] = W[(size_t)(k0 + kk) * N + n0 + (lane & 31)]; }
    asm volatile("s_waitcnt lgkmcnt(0)" ::: "memory");
    const int c = lane & 7;
#pragma unroll
    for (int j = 0; j < 4; ++j) { const int n = (lane >> 3) + 8 * j; const LAS float* s = scr + (8 * c) * 33 + n;
        u32x4 o; o.x = pk2(s[0 * 33], s[1 * 33]); o.y = pk2(s[2 * 33], s[3 * 33]); o.z = pk2(s[4 * 33], s[5 * 33]); o.w = pk2(s[6 * 33], s[7 * 33]);
        *(u32x4*)(WT + (size_t)(r0 + n) * K + k0 + 8 * c) = o; }
    asm volatile("s_waitcnt lgkmcnt(0)" ::: "memory");
}

__device__ __forceinline__ void norm_row(const float* xrow, const float* g, const float* sh, const float* sc, bf16_t* orow, float* orow_f32, int lane) {
    const f32x4* xr = (const f32x4*)xrow + lane;
    f32x4 v[4]; float s = 0.f;
#pragma unroll
    for (int j = 0; j < 4; ++j) { v[j] = xr[64 * j]; s += (v[j].x * v[j].x + v[j].y * v[j].y) + (v[j].z * v[j].z + v[j].w * v[j].w); }
    const float rstd = 1.f / sqrtf(wave_sum(s) * (1.f / 1024.f) + 1e-6f);
#pragma unroll
    for (int j = 0; j < 4; ++j) {
        const f32x4 gg = ((const f32x4*)g)[lane + 64 * j];
        f32x4 y = v[j] * rstd * gg;
        if (sc) { const f32x4 a = ((const f32x4*)sc)[lane + 64 * j], b = ((const f32x4*)sh)[lane + 64 * j]; y = y * (a + 1.f) + b;
            u32x2 w; w.x = pk2(y.x, y.y); w.y = pk2(y.z, y.w); ((u32x2*)orow)[lane + 64 * j] = w; }
        else ((f32x4*)orow_f32)[lane + 64 * j] = y;
    }
}

#ifndef PROBE_MASK
#define PROBE_MASK 0u
#endif
#define REP(k) for (int rep_ = 0; rep_ < ((((unsigned)PROBE_MASK >> (k)) & 1u) ? 2 : 1); ++rep_)
#ifndef SKIP_SSD
#define SKIP_SSD 0
#endif
#ifndef SKIP_ATT
#define SKIP_ATT 0
#endif
#ifndef SKIP_NA
#define SKIP_NA 0
#endif
#define PHASE_IDS() unsigned char* ws = args.ws; asm volatile("" : "+s"(ws)); int tid_ = threadIdx.x; asm volatile("" : "+v"(tid_)); const int tid = tid_, lane = tid & 63, wave = __builtin_amdgcn_readfirstlane(tid >> 6); \
    const int gw = bx * NWAVES + wave, NGW = G * NWAVES; const size_t gt = (size_t)bx * NTHREADS + tid, NGT = (size_t)G * NTHREADS; (void)lane; (void)gw; (void)NGW; (void)gt; (void)NGT;
#define PHASE_WS() unsigned char* ws = args.ws; asm volatile("" : "+s"(ws));
#define MOD ((float*)(ws + WS_MOD))
#define WIN ((bf16_t*)(ws + WS_WIN))
#define WMO ((bf16_t*)(ws + WS_WMO))
#define WQKV ((bf16_t*)(ws + WS_WQKV))
#define WNAO ((bf16_t*)(ws + WS_WNAO))
#define Zb ((bf16_t*)(ws + WS_Z))
#define XR ((bf16_t*)(ws + WS_XR))
#define BCX ((bf16_t*)(ws + WS_BCX))
#define GU ((bf16_t*)(ws + WS_GU))
#define QKV ((bf16_t*)(ws + WS_QKV))
#define YB ((bf16_t*)(ws + WS_YB))
#define YPART ((bf16_t*)(ws + WS_YPART))
#define XC ((bf16_t*)(ws + WS_XC))
#define YCAT ((bf16_t*)(ws + WS_YCAT))
#define Hb ((bf16_t*)(ws + WS_H))
#define ACT ((bf16_t*)(ws + WS_ACT))
#define ATT ((bf16_t*)(ws + WS_ATT))
#define DTRAW ((float*)(ws + WS_DTRAW))
#define DT ((float*)(ws + WS_DT))
#define OUTY (args.out + OUT_Y)
#define x_lo (args.in[I_XP])
#define x_hi (args.in[I_XS] - (size_t)T_CTX * 1024)
#define IN(k) (lo <= (k) && (k) < hi)
#define MISC_OFF (LDS_BYTES - 64)
#define SEAM(k) do { if (IN(k) && IN((k) + 1)) xcd_barrier((unsigned*)(args.ws + WS_BAR), (volatile LAS unsigned*)(lds + MISC_OFF)); } while (0)


__device__ __forceinline__ int mat_items(int id) { return id == 0 ? 16 * 177 : id == 1 ? 32 * 32 : id <= 5 ? 16 * 88 : id <= 7 ? 44 * 32 : id == 8 ? 16 * 96 : 16 * 32; }
__device__ __forceinline__ void mat_item(const Args& args, unsigned char* ws, int id, int r, LAS float* scr, int lane) {
    if (id == 0) transpose_item(args.in[I_WIN], 1024, NIN_SRC, (bf16_t*)(ws + WS_WIN), 1, scr, r, lane);
    else if (id == 1) transpose_item(args.in[I_WMO], 2048, 1024, (bf16_t*)(ws + WS_WMO), 0, scr, r, lane);
    else if (id <= 5) { const int q = id - 2, layer = q >> 1, up = q & 1;
        transpose_item(args.in[up ? I_WU : I_WG] + (size_t)layer * 1024 * DFF, 1024, DFF, (bf16_t*)(ws + (layer ? WS_WGU1 : WS_WGU0)), 2 + up, scr, r, lane); }
    else if (id <= 7) { const int layer = id - 6;
        transpose_item(args.in[I_WD] + (size_t)layer * DFF * 1024, DFF, 1024, (bf16_t*)(ws + (layer ? WS_WDN1 : WS_WDN0)), 0, scr, r, lane); }
    else if (id == 8) transpose_item(args.in[I_WQKV], 1024, NQKV, (bf16_t*)(ws + WS_WQKV), 0, scr, r, lane);
    else transpose_item(args.in[I_WNAO], 1024, 1024, (bf16_t*)(ws + WS_WNAO), 0, scr, r, lane);
}
template <int STAGE>
__device__ __forceinline__ void prep_stage(const Args& args, LAS unsigned char* lds, const int vb, const int nvb) {
    unsigned char* ws = args.ws; int tid_ = threadIdx.x; asm volatile("" : "+v"(tid_)); const int tid = tid_, lane = tid & 63, wave = __builtin_amdgcn_readfirstlane(tid >> 6);
    constexpr int ada_layer = STAGE == 0 ? 0 : (STAGE == 2 ? 1 : -1);
    if (ada_layer >= 0) {
        LAS float* sv = (LAS float*)lds;
        LAS float* red = (LAS float*)(lds + 12288);
        for (int i = tid; i < 3072; i += NTHREADS) { const int v = i >> 10, k = i & 1023; const float c = v == 0 ? args.in[I_CCTX][k] : args.in[I_C][(v - 1) * 1024 + k]; sv[i] = silu_f(c); }
        __syncthreads();
        for (int cc = vb; cc < 96; cc += nvb) {
            const int layer = ada_layer;
            const int sub = lane >> 4, c4 = (lane & 15) * 4;
            const float* wp = args.in[I_ADAW] + ((size_t)layer * 1024 + wave * 128 + sub) * 6144 + cc * 64 + c4;
            f32x4 a0 = {0.f, 0.f, 0.f, 0.f}, a1 = a0, a2 = a0;
#pragma unroll 8
            for (int it = 0; it < 32; ++it) { const f32x4 w4 = *(const f32x4*)(wp + (size_t)it * 4 * 6144); const int k = wave * 128 + it * 4 + sub;
                a0 += w4 * sv[k]; a1 += w4 * sv[1024 + k]; a2 += w4 * sv[2048 + k]; }
#pragma unroll
            for (int e = 0; e < 4; ++e) { a0[e] += __shfl_xor(a0[e], 16); a0[e] += __shfl_xor(a0[e], 32); a1[e] += __shfl_xor(a1[e], 16); a1[e] += __shfl_xor(a1[e], 32); a2[e] += __shfl_xor(a2[e], 16); a2[e] += __shfl_xor(a2[e], 32); }
            if (lane < 16) { *(LAS f32x4*)(red + (wave * 3 + 0) * 64 + c4) = a0; *(LAS f32x4*)(red + (wave * 3 + 1) * 64 + c4) = a1; *(LAS f32x4*)(red + (wave * 3 + 2) * 64 + c4) = a2; }
            __syncthreads();
            if (tid < 192) { const int v = tid >> 6, c = tid & 63; float s = args.in[I_ADAB][layer * 6144 + cc * 64 + c];
#pragma unroll
                for (int w = 0; w < 8; ++w) s += red[(w * 3 + v) * 64 + c];
                ((float*)(ws + WS_MOD))[(layer * 3 + v) * 6144 + cc * 64 + c] = s; }
            __syncthreads();
        }
    }
    LAS float* scr = (LAS float*)(lds + 32768 + wave * 8448);
    constexpr int NID = STAGE == 0 ? 2 : (STAGE == 1 ? 3 : 5);
    constexpr int IDS[3][5] = {{0, 1, 0, 0, 0}, {2, 3, 6, 0, 0}, {4, 5, 7, 8, 9}};
    int total = 0;
#pragma unroll
    for (int j = 0; j < NID; ++j) total += mat_items(IDS[STAGE][j]);
    for (int it = vb * NWAVES + wave; it < total; it += nvb * NWAVES) {
        int r = it;
#pragma unroll
        for (int j = 0; j < NID; ++j) { const int n = mat_items(IDS[STAGE][j]); if (r >= 0 && r < n) mat_item(args, ws, IDS[STAGE][j], r, scr, lane); r -= n; }
    }
    if (STAGE == 0) { u32x4* z = (u32x4*)((bf16_t*)(ws + WS_WIN) + (size_t)NIN_SRC * 1024); const size_t n16 = (size_t)(NIN - NIN_SRC) * 1024 * 2 / 16;
        for (size_t i = (size_t)vb * NTHREADS + tid; i < n16; i += (size_t)nvb * NTHREADS) z[i] = (u32x4){0u, 0u, 0u, 0u}; }
    __syncthreads();
}

template <int layer>
__device__ __forceinline__ void layer_body(const Args& args, LAS unsigned char* lds, cg::grid_group& grid, const int lo, const int hi) {
    const int G = gridDim.x, bx = blockIdx.x;
        const int pb = 1 + layer * 10;
#define modl (MOD + layer * 3 * 6144)
        REP(pb) if (IN(pb)) {
            PHASE_IDS();
            const float* g = args.in[I_NMG] + layer * 1024;
            { const int rpw = (T + NGW - 1) / NGW, r0 = gw * rpw, r1 = min(T, r0 + rpw);
              norm_rows(r0, r1, layer == 0 ? x_lo : OUTY, layer == 0 ? x_hi : OUTY, g, modl, 0, Hb, nullptr, lane); }
        }
        SEAM(pb);
        if constexpr (layer == 0) {
            if (IN(2)) { PHASE_WS(); pg8::Gemm g{Hb, WIN, T, NIN, 1024}; pg8::StaticOrder S; S.init(T, NIN, G, bx); pg8::EpiIn E{Zb, XR, BCX, DTRAW}; pg8::gemm_phase(lds, g, S, E); }
            if constexpr (false) {}
            if ((((unsigned)PROBE_MASK >> (2)) & 1u)) if (IN(2)) { PHASE_WS(); pg8::Gemm g{Hb, WIN, T, NIN, 1024}; pg8::StaticOrder S; S.init(T, NIN, G, bx); pg8::EpiIn E{Zb, XR, BCX, DTRAW}; pg8::gemm_phase(lds, g, S, E); }
            SEAM(2);
            REP(3) if (IN(3)) {
                PHASE_IDS();
                const float* cw = args.in[I_CONVW]; const float* cb = args.in[I_CONVB]; const float* scw = args.in[I_SCW]; const float* dtb = args.in[I_DTB];
                const int ntask = (T / 8) * 320;
                for (int idx = (int)gt; idx < ntask; idx += (int)NGT) {
                    const int rbk = idx / 320, j = idx % 320, t0 = rbk * 8;
                    const int pos0 = t0 < T_CTX ? (t0 & 255) : ((t0 - T_CTX) & 1023), len = t0 < T_CTX ? 256 : 1024;
                    const bool hp = pos0 > 0, hn = pos0 + 8 < len;
                    const u32x4 z4 = {0u, 0u, 0u, 0u};
                    if (j < 192) {
                        const int c0 = 8 * j; const bf16_t* p = XR + (size_t)t0 * 1536 + c0;
                        float wa[8], wb[8], wc_[8], bb[8];
#pragma unroll
                        for (int q = 0; q < 2; ++q) { const f32x4 t0_ = *(const f32x4*)(cw + c0 + 4 * q), t1_ = *(const f32x4*)(cw + 1536 + c0 + 4 * q), t2_ = *(const f32x4*)(cw + 3072 + c0 + 4 * q), t3_ = *(const f32x4*)(cb + c0 + 4 * q);
#pragma unroll
                            for (int e = 0; e < 4; ++e) { wa[4 * q + e] = t0_[e]; wb[4 * q + e] = t1_[e]; wc_[4 * q + e] = t2_[e]; bb[4 * q + e] = t3_[e]; } }
                        u32x4 vr[10];
                        vr[0] = hp ? *(const u32x4*)(p - 1536) : z4;
#pragma unroll
                        for (int r = 0; r < 8; ++r) vr[r + 1] = *(const u32x4*)(p + (size_t)r * 1536);
                        vr[9] = hn ? *(const u32x4*)(p + (size_t)8 * 1536) : z4;
#pragma unroll
                        for (int r = 0; r < 8; ++r) {
                            const u32x4 vm = vr[r], v0 = vr[r + 1], vp = vr[r + 2];
                            float o[8];
#pragma unroll
                            for (int e = 0; e < 4; ++e) {
                                o[2 * e] = silu_f(wa[2 * e] * bflo(vm[e]) + wb[2 * e] * bflo(v0[e]) + wc_[2 * e] * bflo(vp[e]) + bb[2 * e]);
                                o[2 * e + 1] = silu_f(wa[2 * e + 1] * bfhi(vm[e]) + wb[2 * e + 1] * bfhi(v0[e]) + wc_[2 * e + 1] * bfhi(vp[e]) + bb[2 * e + 1]); }
                            u32x4 w; w.x = pk2(o[0], o[1]); w.y = pk2(o[2], o[3]); w.z = pk2(o[4], o[5]); w.w = pk2(o[6], o[7]);
                            *(u32x4*)(XC + (size_t)(t0 + r) * 1536 + c0) = w;
                        }
                    } else {
                        const int c0 = 8 * (j - 192); const bf16_t* p = BCX + (size_t)t0 * 3072 + c0;
                        float wa[8], wb[8], wc_[8];
#pragma unroll
                        for (int q = 0; q < 2; ++q) { const f32x4 t0_ = *(const f32x4*)(scw + c0 + 4 * q), t1_ = *(const f32x4*)(scw + 1024 + c0 + 4 * q), t2_ = *(const f32x4*)(scw + 2048 + c0 + 4 * q);
#pragma unroll
                            for (int e = 0; e < 4; ++e) { wa[4 * q + e] = t0_[e]; wb[4 * q + e] = t1_[e]; wc_[4 * q + e] = t2_[e]; } }
#pragma unroll
                        for (int hf = 0; hf < 2; ++hf) {
                            u32x4 cr[6], xr_[6], bgr[4];
#pragma unroll
                            for (int k = 0; k < 6; ++k) { const int rr = 4 * hf - 1 + k; const bool ok = (rr >= 0 || hp) && (rr <= 7 || hn);
                                cr[k] = ok ? *(const u32x4*)(p + (ptrdiff_t)rr * 3072 + 1024) : z4; xr_[k] = ok ? *(const u32x4*)(p + (ptrdiff_t)rr * 3072 + 2048) : z4; }
#pragma unroll
                            for (int k = 0; k < 4; ++k) bgr[k] = *(const u32x4*)(p + (size_t)(4 * hf + k) * 3072);
                            float pr[6][8];
#pragma unroll
                            for (int k = 0; k < 6; ++k)
#pragma unroll
                                for (int e = 0; e < 4; ++e) { pr[k][2 * e] = bflo(cr[k][e]) * bflo(xr_[k][e]); pr[k][2 * e + 1] = bfhi(cr[k][e]) * bfhi(xr_[k][e]); }
#pragma unroll
                            for (int k = 0; k < 4; ++k) {
                                float o[8];
#pragma unroll
                                for (int e = 0; e < 4; ++e) {
                                    o[2 * e] = bflo(bgr[k][e]) * (wa[2 * e] * pr[k][2 * e] + wb[2 * e] * pr[k + 1][2 * e] + wc_[2 * e] * pr[k + 2][2 * e]);
                                    o[2 * e + 1] = bfhi(bgr[k][e]) * (wa[2 * e + 1] * pr[k][2 * e + 1] + wb[2 * e + 1] * pr[k + 1][2 * e + 1] + wc_[2 * e + 1] * pr[k + 2][2 * e + 1]); }
                                u32x4 w; w.x = pk2(o[0], o[1]); w.y = pk2(o[2], o[3]); w.z = pk2(o[4], o[5]); w.w = pk2(o[6], o[7]);
                                *(u32x4*)(YCAT + (size_t)(t0 + 4 * hf + k) * 2048 + 1024 + c0) = w;
                            }
                        }
                    }
                }
                for (size_t idx = gt; idx < (size_t)T * 8; idx += NGT) {
                    const f32x4 r_ = *(const f32x4*)(DTRAW + idx * 4), b_ = *(const f32x4*)(dtb + (idx & 7) * 4); f32x4 d_;
#pragma unroll
                    for (int e = 0; e < 4; ++e) { const float xv = r_[e] + b_[e]; d_[e] = xv > 20.f ? xv : log1pf(expf(xv)); }
                    *(f32x4*)(DT + idx * 4) = d_;
                }
            }
            SEAM(3);
            REP(4)
            if (IN(4) && !SKIP_SSD) {
                PHASE_IDS();
                constexpr int LS = 136;
                LAS bf16_t* sC = (LAS bf16_t*)lds;
                LAS bf16_t* sB = (LAS bf16_t*)(lds + 34816);
                LAS bf16_t* sBt = (LAS bf16_t*)(lds + 2 * 34816);
                LAS bf16_t* sXt = (LAS bf16_t*)(lds + 3 * 34816);
                LAS bf16_t* sH = (LAS bf16_t*)(lds + 3 * 34816 + 17408);
                LAS float* sArr = (LAS float*)(lds + 3 * 34816 + 2 * 17408);
                LAS float* sIf = sArr, *sSb = sArr + 128, *sDtf = sArr + 256, *sDtb = sArr + 384, *sWf = sArr + 512, *sWb = sArr + 640, *sEf = sArr + 768, *sEb = sArr + 896, *sScal = sArr + 1024;
                const int fr = lane & 15, fq = lane >> 4, w = wave;
                const float* alog = args.in[I_ALOG]; const float* dsk = args.in[I_DSK];
                for (int uu = 0;; ++uu) {
                    int ui;
                    if (G == 256) { if (bx < 64) { if (uu > 1) break; ui = uu == 0 ? bx : 64 + bx; } else { if (uu > 4) break; ui = 128 + (bx - 64) + 192 * uu; } }
                    else { ui = bx + uu * G; if (ui >= 1088) break; }
                    int seq_t0, nc, h, bctx = -1, blat = -1, pass;
                    if (ui < 64) { blat = ui >> 5; h = (ui >> 1) & 15; pass = ui & 1; seq_t0 = T_CTX + blat * 1024; nc = 8; }
                    else { const int ci = ui - 64; bctx = ci >> 5; h = (ci >> 1) & 15; pass = ci & 1; seq_t0 = bctx * 256; nc = 2; }
                    const int grp = h >> 3;
                    const float a_f = -expf(alog[h]), a_b = -expf(alog[16 + h]);
                    {
                        f32x4 hst[4];
#pragma unroll
                        for (int pt = 0; pt < 4; ++pt) {
                            if (blat >= 0) hst[pt] = *(const f32x4*)(args.in[I_STATE] + ((((size_t)blat * 2 + pass) * 16 + h) * 64 + 16 * pt + fr) * 128 + 16 * w + 4 * fq);
                            else hst[pt] = (f32x4){0.f, 0.f, 0.f, 0.f};
                            u32x2 pk; pk.x = pk2(hst[pt][0], hst[pt][1]); pk.y = pk2(hst[pt][2], hst[pt][3]);
                            *(LAS u32x2*)(sH + (16 * pt + fr) * LS + 16 * w + 4 * fq) = pk;
                        }
                        u32x4 rC[4], rB[4], rX[2]; float rd0 = 0.f, rd1 = 0.f;
#define SSD_PREFETCH(cidx) do { const int t0p = seq_t0 + 128 * (cidx); \
                            _Pragma("unroll") for (int i = 0; i < 4; ++i) { const int idx = tid + 512 * i, l = idx >> 4, n8 = (idx & 15) * 8; rC[i] = *(const u32x4*)(XC + (size_t)(t0p + l) * 1536 + 1280 + grp * 128 + n8); } \
                            _Pragma("unroll") for (int i = 0; i < 4; ++i) { const int idx = tid + 512 * i, l = idx & 127, n8 = (idx >> 7) * 8; rB[i] = *(const u32x4*)(XC + (size_t)(t0p + l) * 1536 + 1024 + grp * 128 + n8); } \
                            _Pragma("unroll") for (int i = 0; i < 2; ++i) { const int idx = tid + 512 * i, l = idx & 127, p8 = (idx >> 7) * 8; rX[i] = *(const u32x4*)(XC + (size_t)(t0p + l) * 1536 + h * 64 + p8); } \
                            if (w < 2) { rd0 = DT[(size_t)(t0p + 2 * lane) * 32 + w * 16 + h]; rd1 = DT[(size_t)(t0p + 2 * lane + 1) * 32 + w * 16 + h]; } } while (0)
                        SSD_PREFETCH(pass == 0 ? 0 : nc - 1);
                        for (int cc = 0; cc < nc; ++cc) {
                            const int c = pass == 0 ? cc : nc - 1 - cc;
                            const int t0 = seq_t0 + 128 * c;
                            f32x4 Y[4];
#pragma unroll
                            for (int pt = 0; pt < 4; ++pt) Y[pt] = (f32x4){0.f, 0.f, 0.f, 0.f};
#pragma unroll
                            for (int i = 0; i < 4; ++i) { const int idx = tid + 512 * i, l = idx >> 4, n8 = (idx & 15) * 8; *(LAS u32x4*)(sC + l * LS + n8) = rC[i]; }
#pragma unroll
                            for (int i = 0; i < 4; ++i) { const int idx = tid + 512 * i, l = idx & 127, n8 = (idx >> 7) * 8;
                                const u32x4 vb = rB[i];
                                if (pass == 0) *(LAS u32x4*)(sB + l * LS + n8) = vb;
#pragma unroll
                                for (int e = 0; e < 4; ++e) { sBt[(n8 + 2 * e) * LS + l] = (bf16_t)(vb[e] & 0xffffu); sBt[(n8 + 2 * e + 1) * LS + l] = (bf16_t)(vb[e] >> 16); } }
#pragma unroll
                            for (int i = 0; i < 2; ++i) { const int idx = tid + 512 * i, l = idx & 127, p8 = (idx >> 7) * 8;
                                const u32x4 vx = rX[i];
#pragma unroll
                                for (int e = 0; e < 4; ++e) { sXt[(p8 + 2 * e) * LS + l] = (bf16_t)(vx[e] & 0xffffu); sXt[(p8 + 2 * e + 1) * LS + l] = (bf16_t)(vx[e] >> 16); } }
                            if (w < 2) {
                                const float av = w == 0 ? a_f : a_b;
                                const float d0 = rd0, d1 = rd1;
                                const float e0 = d0 * av, e1 = d1 * av;
                                float s = e0 + e1;
#pragma unroll
                                for (int o = 1; o < 64; o <<= 1) { const float tt = __shfl_up(s, o); if (lane >= o) s += tt; }
                                const float tot = __shfl(s, 63);
                                if (w == 0) { const float i1 = s, i0 = s - e1;
                                    sIf[2 * lane] = i0; sIf[2 * lane + 1] = i1; sDtf[2 * lane] = d0; sDtf[2 * lane + 1] = d1;
                                    sWf[2 * lane] = __expf(tot - i0) * d0; sWf[2 * lane + 1] = __expf(tot - i1) * d1; sEf[2 * lane] = __expf(i0); sEf[2 * lane + 1] = __expf(i1);
                                    if (lane == 0) sScal[0] = __expf(tot);
                                } else { const float s0 = tot - (s - e0 - e1), s1 = tot - (s - e1);
                                    sSb[2 * lane] = s0; sSb[2 * lane + 1] = s1; sDtb[2 * lane] = d0; sDtb[2 * lane + 1] = d1;
                                    sWb[2 * lane] = __expf(tot - s0) * d0; sWb[2 * lane + 1] = __expf(tot - s1) * d1; sEb[2 * lane] = __expf(s0); sEb[2 * lane + 1] = __expf(s1);
                                    if (lane == 0) sScal[1] = __expf(tot);
                                }
                            }
                            LDS_BARRIER();
                            if (cc + 1 < nc) SSD_PREFETCH(pass == 0 ? cc + 1 : nc - 2 - cc);
                            const int l = 16 * w + fr;
                            bf16x8 cfrag[4];
#pragma unroll
                            for (int ks = 0; ks < 4; ++ks) cfrag[ks] = *(const LAS bf16x8*)(sC + l * LS + 32 * ks + 8 * fq);
                            if (pass == 0) {
#pragma unroll
                                for (int pt = 0; pt < 4; ++pt) Y[pt] = (f32x4){0.f, 0.f, 0.f, 0.f};
                                const float If_l = sIf[l], Sb_l = sSb[l];
#pragma unroll
                                for (int u = 0; u < 4; ++u) {
                                    unsigned mw[4];
#pragma unroll
                                    for (int hh = 0; hh < 2; ++hh) {
                                        const int st = 2 * u + hh;
                                        f32x4 gacc = {0.f, 0.f, 0.f, 0.f};
#pragma unroll
                                        for (int ks = 0; ks < 4; ++ks) { const bf16x8 bfrag = *(const LAS bf16x8*)(sB + (16 * st + fr) * LS + 32 * ks + 8 * fq); gacc = MFMA16(bfrag, cfrag[ks], gacc); }
                                        const int s0 = 16 * st + 4 * fq;
                                        f32x4 fac = {0.f, 0.f, 0.f, 0.f};
                                        if (st <= w) { const f32x4 is = *(const LAS f32x4*)(sIf + s0), ds = *(const LAS f32x4*)(sDtf + s0);
#pragma unroll
                                            for (int e = 0; e < 4; ++e) fac[e] += (s0 + e <= l) ? __expf(fminf(If_l - is[e], 0.f)) * ds[e] : 0.f; }
                                        if (st >= w) { const f32x4 ss = *(const LAS f32x4*)(sSb + s0), ds = *(const LAS f32x4*)(sDtb + s0);
#pragma unroll
                                            for (int e = 0; e < 4; ++e) fac[e] += (s0 + e >= l) ? __expf(fminf(Sb_l - ss[e], 0.f)) * ds[e] : 0.f; }
                                        gacc = gacc * fac;
                                        mw[2 * hh] = pk2(gacc[0], gacc[1]); mw[2 * hh + 1] = pk2(gacc[2], gacc[3]);
                                    }
                                    u32x4 mf = {mw[0], mw[1], mw[2], mw[3]};
                                    const bf16x8 mfrag = __builtin_bit_cast(bf16x8, mf);
#pragma unroll
                                    for (int pt = 0; pt < 4; ++pt) {
                                        const u32x2 xa = *(const LAS u32x2*)(sXt + (16 * pt + fr) * LS + 32 * u + 4 * fq), xb = *(const LAS u32x2*)(sXt + (16 * pt + fr) * LS + 32 * u + 16 + 4 * fq);
                                        u32x4 xf = {xa.x, xa.y, xb.x, xb.y};
                                        Y[pt] = MFMA16(__builtin_bit_cast(bf16x8, xf), mfrag, Y[pt]);
                                    }
                                }
                            }
                            if (!(bctx >= 0 && cc == 0)) {
                                const float el = pass == 0 ? sEf[l] : sEb[l];
#pragma unroll
                                for (int pt = 0; pt < 4; ++pt) { f32x4 yi = {0.f, 0.f, 0.f, 0.f};
#pragma unroll
                                    for (int ks = 0; ks < 4; ++ks) { const bf16x8 hf = *(const LAS bf16x8*)(sH + (16 * pt + fr) * LS + 32 * ks + 8 * fq); yi = MFMA16(hf, cfrag[ks], yi); }
                                    Y[pt] += yi * el; }
                            }
                            {
                                bf16_t* yp = (pass == 0 ? YPART : YB) + ((((size_t)(t0 >> 7)) * 16 + h) * 512 + tid) * 16;
                                u32x4 y0, y1;
                                y0.x = pk2(Y[0][0], Y[0][1]); y0.y = pk2(Y[0][2], Y[0][3]); y0.z = pk2(Y[1][0], Y[1][1]); y0.w = pk2(Y[1][2], Y[1][3]);
                                y1.x = pk2(Y[2][0], Y[2][1]); y1.y = pk2(Y[2][2], Y[2][3]); y1.z = pk2(Y[3][0], Y[3][1]); y1.w = pk2(Y[3][2], Y[3][3]);
                                *(u32x4*)yp = y0; *(u32x4*)(yp + 8) = y1;
                            }
                            LDS_BARRIER();
                            {
                                const float dec = sScal[pass];
                                const LAS float* sW = pass == 0 ? sWf : sWb;
#pragma unroll
                                for (int pt = 0; pt < 4; ++pt) hst[pt] = hst[pt] * dec;
#pragma unroll
                                for (int ks = 0; ks < 4; ++ks) {
                                    const u32x4 br = *(const LAS u32x4*)(sBt + (16 * w + fr) * LS + 32 * ks + 8 * fq);
                                    const f32x4 w0 = *(const LAS f32x4*)(sW + 32 * ks + 8 * fq), w1 = *(const LAS f32x4*)(sW + 32 * ks + 8 * fq + 4);
                                    u32x4 bs; bs.x = pk2(bflo(br.x) * w0[0], bfhi(br.x) * w0[1]); bs.y = pk2(bflo(br.y) * w0[2], bfhi(br.y) * w0[3]);
                                    bs.z = pk2(bflo(br.z) * w1[0], bfhi(br.z) * w1[1]); bs.w = pk2(bflo(br.w) * w1[2], bfhi(br.w) * w1[3]);
                                    const bf16x8 bfrag = __builtin_bit_cast(bf16x8, bs);
#pragma unroll
                                    for (int pt = 0; pt < 4; ++pt) {
                                        const bf16x8 xf = *(const LAS bf16x8*)(sXt + (16 * pt + fr) * LS + 32 * ks + 8 * fq);
                                        hst[pt] = MFMA16(bfrag, xf, hst[pt]);
                                    }
                                }
#pragma unroll
                                for (int pt = 0; pt < 4; ++pt) { u32x2 pk; pk.x = pk2(hst[pt][0], hst[pt][1]); pk.y = pk2(hst[pt][2], hst[pt][3]);
                                    *(LAS u32x2*)(sH + (16 * pt + fr) * LS + 16 * w + 4 * fq) = pk; }
                            }
                            LDS_BARRIER();
                        }
                        if (bctx >= 0) {
                            float* so = args.out + OUT_STATE + ((((size_t)bctx * 2 + pass) * 16 + h) * 64) * 128;
#pragma unroll
                            for (int pt = 0; pt < 4; ++pt) *(f32x4*)(so + (size_t)(16 * pt + fr) * 128 + 16 * w + 4 * fq) = hst[pt];
                        }
                    }
                }
            }
            SEAM(4);
            REP(5) if (IN(5)) {
                PHASE_IDS();
                const float* g = args.in[I_SNG]; const float* dsk = args.in[I_DSK];
                const int hh = lane >> 2, fq = lane & 3;
                const float Dsum = dsk[hh] + dsk[16 + hh];
                for (int m = gw; m < T; m += NGW) {
                    const int gc = m >> 7, l = m & 127, w = l >> 4, fr = l & 15;
                    const size_t base = ((((size_t)gc * 16 + hh) * 512) + w * 64 + fq * 16 + fr) * 16;
                    f32x4 y[4]; float ss = 0.f;
#pragma unroll
                    for (int pt = 0; pt < 4; ++pt) {
                        const int c0 = hh * 64 + 16 * pt + 4 * fq;
                        const u32x2 yfp = *(const u32x2*)(YPART + base + 4 * pt), ybp = *(const u32x2*)(YB + base + 4 * pt);
                        const float yf[4] = {bflo(yfp.x), bfhi(yfp.x), bflo(yfp.y), bfhi(yfp.y)}, yb[4] = {bflo(ybp.x), bfhi(ybp.x), bflo(ybp.y), bfhi(ybp.y)};
                        const u32x2 xv = *(const u32x2*)(XC + (size_t)m * 1536 + c0), zv = *(const u32x2*)(Zb + (size_t)m * 1024 + c0);
                        const float xs[4] = {bflo(xv.x), bfhi(xv.x), bflo(xv.y), bfhi(xv.y)}, zs[4] = {bflo(zv.x), bfhi(zv.x), bflo(zv.y), bfhi(zv.y)};
#pragma unroll
                        for (int e = 0; e < 4; ++e) { const float o = (yf[e] + yb[e] + xs[e] * Dsum) * silu_f(zs[e]); y[pt][e] = o; ss += o * o; }
                    }
                    const float rstd = 1.f / sqrtf(wave_sum(ss) * (1.f / 1024.f) + 1e-6f);
#pragma unroll
                    for (int pt = 0; pt < 4; ++pt) { const int c0 = hh * 64 + 16 * pt + 4 * fq; const f32x4 gg = *(const f32x4*)(g + c0);
                        u32x2 o; o.x = pk2(y[pt][0] * rstd * gg[0], y[pt][1] * rstd * gg[1]); o.y = pk2(y[pt][2] * rstd * gg[2], y[pt][3] * rstd * gg[3]);
                        *(u32x2*)(YCAT + (size_t)m * 2048 + c0) = o; }
                }
            }
            SEAM(5);
            if (IN(6)) { if (G > 160 && bx >= 160) prep_stage<1>(args, lds, bx - 160, G - 160); else { PHASE_WS(); pg8::Gemm g{YCAT, WMO, T, 1024, 2048}; pg8::StaticOrder S; S.init(T, 1024, G, bx); pg8::EpiRes E{x_lo, x_hi, OUTY, modl + 2048}; pg8::gemm_phase(lds, g, S, E); } if (G <= 160) prep_stage<1>(args, lds, bx, G); }
            if constexpr (false) {}
            if ((((unsigned)PROBE_MASK >> (6)) & 1u)) if (IN(6)) { PHASE_WS(); pg8::Gemm g{YCAT, WMO, T, 1024, 2048}; pg8::StaticOrder S; S.init(T, 1024, G, bx); pg8::EpiRes E{x_lo, x_hi, OUTY, modl + 2048}; pg8::gemm_phase(lds, g, S, E); }
            SEAM(6);
        } else {
            if (IN(12)) { PHASE_WS(); pg8::Gemm g{Hb, WQKV, T, NQKV, 1024}; pg8::StaticOrder S; S.init(T, NQKV, G, bx); pg8::EpiQKV E{QKV, args.out + OUT_K, args.out + OUT_V}; pg8::gemm_phase(lds, g, S, E); }
            if constexpr (false) {}
            if ((((unsigned)PROBE_MASK >> (12)) & 1u)) if (IN(12)) { PHASE_WS(); pg8::Gemm g{Hb, WQKV, T, NQKV, 1024}; pg8::StaticOrder S; S.init(T, NQKV, G, bx); pg8::EpiQKV E{QKV, args.out + OUT_K, args.out + OUT_V}; pg8::gemm_phase(lds, g, S, E); }
            SEAM(12);
            REP(13)
            if (IN(13) && !SKIP_ATT) {
                PHASE_IDS();
                const int fr = lane & 15, fq = lane >> 4, w = wave;
                const float SCL = 0.125f * 1.4426950408889634f;
                for (int unit = bx; unit < 256 && !SKIP_NA; unit += G) {
                    const int b = unit >> 7, h = (unit >> 3) & 15, rp = unit & 7;
                    const int r = 2 * rp + (w >> 2), j = w & 3;
                    const int rb = min(max(2 * rp - 4, 0), 8), rs = min(max(r - 4, 0), 8), ro = rs - rb;
                    const int cs = min(max(16 * j - 8, 0), 32);
                    constexpr int KS = 72;
                    LAS bf16_t* sKc = (LAS bf16_t*)lds;
                    LAS bf16_t* sKl = (LAS bf16_t*)(lds + 36864);
                    LAS float* sRpb = (LAS float*)(lds + 36864 + 82944);
                    const size_t tokb = (size_t)T_CTX + (size_t)b * 1024;
                    for (int idx = tid; idx < 256 * 8; idx += NTHREADS) { const int key = idx >> 3, d8 = (idx & 7) * 8;
                        const float* src = args.in[I_CK] + (((size_t)b * 256 + key) * 16 + h) * 64 + d8;
                        const f32x4 a = *(const f32x4*)src, c = *(const f32x4*)(src + 4);
                        u32x4 o; o.x = pk2(a[0], a[1]); o.y = pk2(a[2], a[3]); o.z = pk2(c[0], c[1]); o.w = pk2(c[2], c[3]);
                        *(LAS u32x4*)(sKc + key * KS + d8) = o; }
                    for (int idx = tid; idx < 576 * 8; idx += NTHREADS) { const int key = idx >> 3, d8 = (idx & 7) * 8; const int gr = rb + (key >> 6);
                        if (gr < 16) *(LAS u32x4*)(sKl + key * KS + d8) = *(const u32x4*)(QKV + (tokb + gr * 64 + (key & 63)) * NQKV + 1024 + h * 64 + d8); }
                    for (int idx = tid; idx < 465; idx += NTHREADS) sRpb[idx] = args.in[I_RPB][h * 465 + idx];
                    __syncthreads();
                    const size_t qtok = tokb + r * 64 + 16 * j + fr;
                    bf16x8 qf[2];
#pragma unroll
                    for (int ks = 0; ks < 2; ++ks) qf[ks] = *(const bf16x8*)(QKV + qtok * NQKV + h * 64 + 32 * ks + 8 * fq);
                    unsigned P1[8][4], P2[8][4]; float m1, l1, m2, l2;
                    {
                        f32x4 sc[16];
#pragma unroll
                        for (int t = 0; t < 16; ++t) { f32x4 a = {0.f, 0.f, 0.f, 0.f};
#pragma unroll
                            for (int ks = 0; ks < 2; ++ks) { const bf16x8 kf = *(const LAS bf16x8*)(sKc + (16 * t + fr) * KS + 32 * ks + 8 * fq); a = MFMA16(kf, qf[ks], a); }
                            sc[t] = a * SCL; }
                        float mx = -1e30f;
#pragma unroll
                        for (int t = 0; t < 16; ++t)
#pragma unroll
                            for (int e = 0; e < 4; ++e) mx = fmaxf(mx, sc[t][e]);
                        mx = fmaxf(mx, __shfl_xor(mx, 16)); mx = fmaxf(mx, __shfl_xor(mx, 32));
                        float sum = 0.f;
#pragma unroll
                        for (int t = 0; t < 16; ++t)
#pragma unroll
                            for (int e = 0; e < 4; ++e) { const float p = __builtin_amdgcn_exp2f(sc[t][e] - mx); sc[t][e] = p; sum += p; }
                        sum += __shfl_xor(sum, 16); sum += __shfl_xor(sum, 32);
                        m1 = mx; l1 = sum;
#pragma unroll
                        for (int u = 0; u < 8; ++u) { P1[u][0] = pk2(sc[2 * u][0], sc[2 * u][1]); P1[u][1] = pk2(sc[2 * u][2], sc[2 * u][3]); P1[u][2] = pk2(sc[2 * u + 1][0], sc[2 * u + 1][1]); P1[u][3] = pk2(sc[2 * u + 1][2], sc[2 * u + 1][3]); }
                    }
                    {
                        const int qcol = 16 * j + fr, cstart = min(max(qcol - 8, 0), 48);
                        f32x4 sc[16];
#pragma unroll
                        for (int t = 0; t < 16; ++t) { f32x4 a = {0.f, 0.f, 0.f, 0.f};
                            const int kr = t >> 1, kc0 = 16 * (t & 1);
#pragma unroll
                            for (int ks = 0; ks < 2; ++ks) { const bf16x8 kf = *(const LAS bf16x8*)(sKl + ((ro + kr) * 64 + cs + kc0 + fr) * KS + 32 * ks + 8 * fq); a = MFMA16(kf, qf[ks], a); }
                            const int dr = rs + kr - r + 7;
#pragma unroll
                            for (int e = 0; e < 4; ++e) { const int col = cs + kc0 + 4 * fq + e; const int dc = min(max(col - qcol + 15, 0), 30);
                                const bool ok = col >= cstart && col < cstart + 16;
                                a[e] = ok ? (a[e] * 0.125f + sRpb[dr * 31 + dc]) * 1.4426950408889634f : -1e30f; }
                            sc[t] = a; }
                        float mx = -1e30f;
#pragma unroll
                        for (int t = 0; t < 16; ++t)
#pragma unroll
                            for (int e = 0; e < 4; ++e) mx = fmaxf(mx, sc[t][e]);
                        mx = fmaxf(mx, __shfl_xor(mx, 16)); mx = fmaxf(mx, __shfl_xor(mx, 32));
                        float sum = 0.f;
#pragma unroll
                        for (int t = 0; t < 16; ++t)
#pragma unroll
                            for (int e = 0; e < 4; ++e) { const float p = __builtin_amdgcn_exp2f(sc[t][e] - mx); sc[t][e] = p; sum += p; }
                        sum += __shfl_xor(sum, 16); sum += __shfl_xor(sum, 32);
                        m2 = mx; l2 = sum;
#pragma unroll
                        for (int u = 0; u < 8; ++u) { P2[u][0] = pk2(sc[2 * u][0], sc[2 * u][1]); P2[u][1] = pk2(sc[2 * u][2], sc[2 * u][3]); P2[u][2] = pk2(sc[2 * u + 1][0], sc[2 * u + 1][1]); P2[u][3] = pk2(sc[2 * u + 1][2], sc[2 * u + 1][3]); }
                    }
                    const float mm = fmaxf(m1, m2), f1 = __builtin_amdgcn_exp2f(m1 - mm), f2 = __builtin_amdgcn_exp2f(m2 - mm);
                    const float inv = 1.f / (l1 * f1 + l2 * f2), g1 = f1 * inv, g2 = f2 * inv;
                    __syncthreads();
                    constexpr int VCS = 264, VLS = 584;
                    LAS bf16_t* sVc = (LAS bf16_t*)lds;
                    LAS bf16_t* sVl = (LAS bf16_t*)(lds + 33792);
                    for (int idx = tid; idx < 256 * 8; idx += NTHREADS) { const int key = idx & 255, d8 = (idx >> 8) * 8;
                        const float* src = args.in[I_CV] + (((size_t)b * 256 + key) * 16 + h) * 64 + d8;
                        const f32x4 a = *(const f32x4*)src, c = *(const f32x4*)(src + 4);
#pragma unroll
                        for (int e = 0; e < 4; ++e) { sVc[(d8 + e) * VCS + key] = (bf16_t)f2bf(a[e]); sVc[(d8 + 4 + e) * VCS + key] = (bf16_t)f2bf(c[e]); } }
                    for (int idx = tid; idx < 576 * 8; idx += NTHREADS) { const int key = idx % 576, d8 = (idx / 576) * 8; const int gr = rb + (key >> 6);
                        if (gr < 16) { const u32x4 v = *(const u32x4*)(QKV + (tokb + gr * 64 + (key & 63)) * NQKV + 2048 + h * 64 + d8);
#pragma unroll
                            for (int e = 0; e < 4; ++e) { sVl[(d8 + 2 * e) * VLS + key] = (bf16_t)(v[e] & 0xffffu); sVl[(d8 + 2 * e + 1) * VLS + key] = (bf16_t)(v[e] >> 16); } } }
                    __syncthreads();
                    f32x4 O1[4], O2[4];
#pragma unroll
                    for (int dt = 0; dt < 4; ++dt) { O1[dt] = (f32x4){0.f, 0.f, 0.f, 0.f}; O2[dt] = (f32x4){0.f, 0.f, 0.f, 0.f}; }
#pragma unroll
                    for (int u = 0; u < 8; ++u) {
                        const u32x4 pf = {P1[u][0], P1[u][1], P1[u][2], P1[u][3]};
#pragma unroll
                        for (int dt = 0; dt < 4; ++dt) { const u32x2 va = *(const LAS u32x2*)(sVc + (16 * dt + fr) * VCS + 32 * u + 4 * fq), vb = *(const LAS u32x2*)(sVc + (16 * dt + fr) * VCS + 32 * u + 16 + 4 * fq);
                            u32x4 vf = {va.x, va.y, vb.x, vb.y}; O1[dt] = MFMA16(__builtin_bit_cast(bf16x8, vf), __builtin_bit_cast(bf16x8, pf), O1[dt]); }
                    }
#pragma unroll
                    for (int u = 0; u < 8; ++u) {
                        const u32x4 pf = {P2[u][0], P2[u][1], P2[u][2], P2[u][3]};
                        const int kb = (ro + u) * 64 + cs + 4 * fq;
#pragma unroll
                        for (int dt = 0; dt < 4; ++dt) { const u32x2 va = *(const LAS u32x2*)(sVl + (16 * dt + fr) * VLS + kb), vb = *(const LAS u32x2*)(sVl + (16 * dt + fr) * VLS + kb + 16);
                            u32x4 vf = {va.x, va.y, vb.x, vb.y}; O2[dt] = MFMA16(__builtin_bit_cast(bf16x8, vf), __builtin_bit_cast(bf16x8, pf), O2[dt]); }
                    }
#pragma unroll
                    for (int dt = 0; dt < 4; ++dt) { const f32x4 o = O1[dt] * g1 + O2[dt] * g2; u32x2 pk; pk.x = pk2(o[0], o[1]); pk.y = pk2(o[2], o[3]);
                        *(u32x2*)(ATT + qtok * 1024 + h * 64 + 16 * dt + 4 * fq) = pk; }
                    __syncthreads();
                }
                for (int unit = bx; unit < 512; unit += G) {
                    const int b = unit >> 4, h = unit & 15;
                    constexpr int KS = 72, VS = 264;
                    LAS bf16_t* sK = (LAS bf16_t*)lds;
                    LAS bf16_t* sVt = (LAS bf16_t*)(lds + 36864);
                    const size_t tokb = (size_t)b * 256;
                    for (int idx = tid; idx < 256 * 8; idx += NTHREADS) { const int key = idx >> 3, d8 = (idx & 7) * 8;
                        *(LAS u32x4*)(sK + key * KS + d8) = *(const u32x4*)(QKV + (tokb + key) * NQKV + 1024 + h * 64 + d8); }
                    for (int idx = tid; idx < 256 * 8; idx += NTHREADS) { const int key = idx & 255, d8 = (idx >> 8) * 8;
                        const u32x4 v = *(const u32x4*)(QKV + (tokb + key) * NQKV + 2048 + h * 64 + d8);
#pragma unroll
                        for (int e = 0; e < 4; ++e) { sVt[(d8 + 2 * e) * VS + key] = (bf16_t)(v[e] & 0xffffu); sVt[(d8 + 2 * e + 1) * VS + key] = (bf16_t)(v[e] >> 16); } }
                    __syncthreads();
                    for (int qt = 0; qt < 2; ++qt) {
                        const size_t qtok = tokb + 32 * w + 16 * qt + fr;
                        bf16x8 qf[2];
#pragma unroll
                        for (int ks = 0; ks < 2; ++ks) qf[ks] = *(const bf16x8*)(QKV + qtok * NQKV + h * 64 + 32 * ks + 8 * fq);
                        f32x4 sc[16];
#pragma unroll
                        for (int t = 0; t < 16; ++t) { f32x4 a = {0.f, 0.f, 0.f, 0.f};
#pragma unroll
                            for (int ks = 0; ks < 2; ++ks) { const bf16x8 kf = *(const LAS bf16x8*)(sK + (16 * t + fr) * KS + 32 * ks + 8 * fq); a = MFMA16(kf, qf[ks], a); }
                            sc[t] = a * SCL; }
                        float mx = -1e30f;
#pragma unroll
                        for (int t = 0; t < 16; ++t)
#pragma unroll
                            for (int e = 0; e < 4; ++e) mx = fmaxf(mx, sc[t][e]);
                        mx = fmaxf(mx, __shfl_xor(mx, 16)); mx = fmaxf(mx, __shfl_xor(mx, 32));
                        float sum = 0.f;
#pragma unroll
                        for (int t = 0; t < 16; ++t)
#pragma unroll
                            for (int e = 0; e < 4; ++e) { const float p = __builtin_amdgcn_exp2f(sc[t][e] - mx); sc[t][e] = p; sum += p; }
                        sum += __shfl_xor(sum, 16); sum += __shfl_xor(sum, 32);
                        const float inv = 1.f / sum;
                        f32x4 O[4];
#pragma unroll
                        for (int dt = 0; dt < 4; ++dt) O[dt] = (f32x4){0.f, 0.f, 0.f, 0.f};
#pragma unroll
                        for (int u = 0; u < 8; ++u) {
                            u32x4 pf; pf.x = pk2(sc[2 * u][0], sc[2 * u][1]); pf.y = pk2(sc[2 * u][2], sc[2 * u][3]); pf.z = pk2(sc[2 * u + 1][0], sc[2 * u + 1][1]); pf.w = pk2(sc[2 * u + 1][2], sc[2 * u + 1][3]);
#pragma unroll
                            for (int dt = 0; dt < 4; ++dt) { const u32x2 va = *(const LAS u32x2*)(sVt + (16 * dt + fr) * VS + 32 * u + 4 * fq), vb = *(const LAS u32x2*)(sVt + (16 * dt + fr) * VS + 32 * u + 16 + 4 * fq);
                                u32x4 vf = {va.x, va.y, vb.x, vb.y}; O[dt] = MFMA16(__builtin_bit_cast(bf16x8, vf), __builtin_bit_cast(bf16x8, pf), O[dt]); }
                        }
#pragma unroll
                        for (int dt = 0; dt < 4; ++dt) { u32x2 pk; pk.x = pk2(O[dt][0] * inv, O[dt][1] * inv); pk.y = pk2(O[dt][2] * inv, O[dt][3] * inv);
                            *(u32x2*)(ATT + qtok * 1024 + h * 64 + 16 * dt + 4 * fq) = pk; }
                    }
                    __syncthreads();
                }
            }
            SEAM(13);
            if (IN(14)) { PHASE_WS(); pg8::Gemm g{ATT, WNAO, T, 1024, 1024}; pg8::StaticOrder S; S.init(T, 1024, G, bx); pg8::EpiRes E{OUTY, OUTY, OUTY, modl + 2048}; pg8::gemm_phase(lds, g, S, E); }
            SEAM(14);
        }
        const int pf = layer == 0 ? 7 : 15;
        REP(pf) if (IN(pf)) {
            PHASE_IDS();
            const float* g = args.in[I_NFG] + layer * 1024;
            { const int rpw = (T + NGW - 1) / NGW, r0 = gw * rpw, r1 = min(T, r0 + rpw);
              norm_rows(r0, r1, OUTY, OUTY, g, modl, 3072, Hb, nullptr, lane); }
            const bf16_t* WG = (const bf16_t*)(ws + (layer ? WS_WGU1 : WS_WGU0));
            float* HALO = (float*)(ws + WS_HALO);
            for (int it = gw; it < 12 * 176; it += NGW) {
                const int hr = it / 176, cb = it % 176;
                const int sq = hr / 6, kk = (hr % 6) >> 1, side = hr & 1;
                const int m = T_CTX + sq * 1024 + 256 * (kk + 1) - 1 + side;
                const float* sh = modl + (1 + sq) * 6144 + 3072; const float* sc = modl + (1 + sq) * 6144 + 4096;
                const f32x4* xr = (const f32x4*)(OUTY + (size_t)m * 1024) + lane;
                f32x4 v[4]; float ss = 0.f;
#pragma unroll
                for (int j = 0; j < 4; ++j) { v[j] = xr[64 * j]; ss += (v[j].x * v[j].x + v[j].y * v[j].y) + (v[j].z * v[j].z + v[j].w * v[j].w); }
                const float rstd = 1.f / sqrtf(wave_sum(ss) * (1.f / 1024.f) + 1e-6f);
#pragma unroll
                for (int j = 0; j < 4; ++j) { const f32x4 gg = ((const f32x4*)g)[lane + 64 * j], a = ((const f32x4*)sc)[lane + 64 * j], b = ((const f32x4*)sh)[lane + 64 * j];
                    const f32x4 y = v[j] * rstd * gg * (a + 1.f) + b; const unsigned p0 = pk2(y.x, y.y), p1 = pk2(y.z, y.w);
                    v[j] = (f32x4){bflo(p0), bfhi(p0), bflo(p1), bfhi(p1)}; }
#pragma unroll
                for (int cbat = 0; cbat < 2; ++cbat) {
                    u32x2 wv[8][4];
#pragma unroll
                    for (int c = 0; c < 8; ++c) { const int gc = cb * 16 + cbat * 8 + c; const bf16_t* wrow = WG + (size_t)(256 * (gc >> 7) + (gc & 127)) * 1024;
#pragma unroll
                        for (int j = 0; j < 4; ++j) wv[c][j] = ((const u32x2*)wrow)[lane + 64 * j]; }
                    float dd[8];
#pragma unroll
                    for (int c = 0; c < 8; ++c) { float d = 0.f;
#pragma unroll
                        for (int j = 0; j < 4; ++j) d += v[j].x * bflo(wv[c][j].x) + v[j].y * bfhi(wv[c][j].x) + v[j].z * bflo(wv[c][j].y) + v[j].w * bfhi(wv[c][j].y);
                        dd[c] = wave_sum(d); }
                    if (lane == 0) { float* hp_ = HALO + (size_t)hr * DFF + cb * 16 + cbat * 8;
                        *(f32x4*)hp_ = (f32x4){dd[0], dd[1], dd[2], dd[3]}; *(f32x4*)(hp_ + 4) = (f32x4){dd[4], dd[5], dd[6], dd[7]}; }
                }
            }
        }
        SEAM(pf);
        if (IN(pf + 1)) { PHASE_WS(); pg8::Gemm g{Hb, (const bf16_t*)(ws + (layer ? WS_WGU1 : WS_WGU0)), T, NGU, 1024}; pg8::StaticOrder S; S.init(T, NGU, G, bx); pg8::EpiGUF E{ACT, args.in[I_FCW] + (size_t)layer * 3 * DFF, (const float*)(ws + WS_HALO), (LAS float*)(lds + 131072)}; pg8::gemm_phase(lds, g, S, E); }
        if constexpr (false) {}
        if ((((unsigned)PROBE_MASK >> ((pf + 1))) & 1u)) if (IN(pf + 1)) { PHASE_WS(); pg8::Gemm g{Hb, (const bf16_t*)(ws + (layer ? WS_WGU1 : WS_WGU0)), T, NGU, 1024}; pg8::StaticOrder S; S.init(T, NGU, G, bx); pg8::EpiGUF E{ACT, args.in[I_FCW] + (size_t)layer * 3 * DFF, (const float*)(ws + WS_HALO), (LAS float*)(lds + 131072)}; pg8::gemm_phase(lds, g, S, E); }
        SEAM(pf + 1);
        if (IN(pf + 3)) { if (layer == 0 && G > 160 && bx >= 160) prep_stage<2>(args, lds, bx - 160, G - 160); else { PHASE_WS(); pg8::Gemm g{ACT, (const bf16_t*)(ws + (layer ? WS_WDN1 : WS_WDN0)), T, 1024, DFF}; pg8::StaticOrder S; S.init(T, 1024, G, bx); pg8::EpiRes E{OUTY, OUTY, OUTY, modl + 5120}; pg8::gemm_phase(lds, g, S, E); } if (layer == 0 && G <= 160) prep_stage<2>(args, lds, bx, G); }
        SEAM(pf + 3);

}

__global__ void __launch_bounds__(NTHREADS, 2) fwd_mega(Args args) {
    extern __shared__ __attribute__((aligned(16))) unsigned char lds_raw[];
    LAS unsigned char* lds = (LAS unsigned char*)lds_raw;
    cg::grid_group grid = cg::this_grid();
    const int G = gridDim.x, bx = blockIdx.x;
    const int lo = args.ph_lo, hi = args.ph_hi;
    if (threadIdx.x < 16) ((volatile LAS unsigned*)(lds + MISC_OFF))[threadIdx.x] = 0u;
    __syncthreads();
    if (hi - lo > 1 && threadIdx.x == 0) (void)xb_add(&((unsigned*)(args.ws + WS_BAR))[XB_XCNT(xb_xcc_id())], 1u);
    if (hi > 1000) grid.sync();
    if (IN(0)) prep_stage<0>(args, lds, blockIdx.x, gridDim.x);
    SEAM(0);

    layer_body<0>(args, lds, grid, lo, hi);
    layer_body<1>(args, lds, grid, lo, hi);
    if (IN(19)) {
        PHASE_IDS();
        const float* g = args.in[I_FNG];
        { const int rpw = (T + NGW - 1) / NGW, r0 = gw * rpw, r1 = min(T, r0 + rpw); norm_rows(r0, r1, OUTY, OUTY, g, nullptr, 0, nullptr, OUTY, lane); }
    }
#undef IN
#undef SEAM
}

#ifndef N_LAUNCH_PER_PHASE
#define N_LAUNCH_PER_PHASE 0
#endif
extern "C" void kernel_launch(void* const* d_in, const int* in_sizes, int n_in, void* d_out, int out_size, void* d_ws, size_t ws_size, hipStream_t stream) {
    static int grid = 0;
    if (grid == 0) {
        if (n_in != 28 || ws_size < WS_END) { fprintf(stderr, "kernel_launch: unexpected n_in %d or ws %zu (< %zu)\n", n_in, ws_size, (size_t)WS_END); grid = -1; return; }
        int dev = 0, cus = 0, per_cu = 0;
        hipGetDevice(&dev); hipDeviceGetAttribute(&cus, hipDeviceAttributeMultiprocessorCount, dev);
        if (hipFuncSetAttribute((const void*)fwd_mega, hipFuncAttributeMaxDynamicSharedMemorySize, LDS_BYTES) != hipSuccess) { fprintf(stderr, "hipFuncSetAttribute failed\n"); grid = -1; return; }
        if (hipOccupancyMaxActiveBlocksPerMultiprocessor(&per_cu, (const void*)fwd_mega, NTHREADS, LDS_BYTES) != hipSuccess || per_cu < 1) { fprintf(stderr, "occupancy query: %d\n", per_cu); per_cu = 1; }
        (void)hipGetLastError();
        grid = cus;
    }
    if (grid < 0) return;
    if (hipMemsetAsync((char*)d_ws + WS_BAR, 0, 16384, stream) != hipSuccess) { fprintf(stderr, "memset failed\n"); return; }
    Args a{};
    for (int i = 0; i < 28; ++i) a.in[i] = (const float*)d_in[i];
    a.out = (float*)d_out; a.ws = (unsigned char*)d_ws;
#if N_LAUNCH_PER_PHASE
    for (int ph = 0; ph < 20; ++ph) { a.ph_lo = ph; a.ph_hi = ph + 1; hipLaunchKernelGGL(fwd_mega, dim3(grid), dim3(NTHREADS), LDS_BYTES, stream, a); }
#else
    a.ph_lo = 0; a.ph_hi = 20;
    void* kargs[] = {&a};
    hipError_t e = hipLaunchCooperativeKernel((const void*)fwd_mega, dim3(grid), dim3(NTHREADS), kargs, LDS_BYTES, stream);
    if (e != hipSuccess) fprintf(stderr, "cooperative launch failed: %s (grid %d)\n", hipGetErrorString(e), grid);
#endif
}
```

```cpp
#include <hip/hip_runtime.h>
#include <hip/hip_cooperative_groups.h>
#include <cstdio>
#include <cstdint>
namespace cg = cooperative_groups;

#define LAS __attribute__((address_space(3)))
typedef unsigned short bf16_t;
typedef short bf16x8 __attribute__((ext_vector_type(8)));
typedef float f32x4 __attribute__((ext_vector_type(4)));
typedef float f32x2 __attribute__((ext_vector_type(2)));
typedef unsigned u32x4 __attribute__((ext_vector_type(4)));
typedef unsigned u32x2 __attribute__((ext_vector_type(2)));

constexpr int D = 1024, T_CTX = 8192, T_LAT = 2048, T = 10240;
constexpr int NIN_SRC = 5664, NIN = 5888, NGU = 5632, DFF = 2816, NQKV = 3072;
constexpr int NTHREADS = 512, NWAVES = 8;
constexpr int LDS_BYTES = 147456;

constexpr size_t WS_BAR = 0;
constexpr size_t WS_MOD = 16384;
constexpr size_t WS_WIN = 262144;
constexpr size_t WS_WMO = WS_WIN + (size_t)NIN * 1024 * 2;
constexpr size_t WS_WGU0 = WS_WMO + (size_t)1024 * 2048 * 2;
constexpr size_t WS_WGU1 = WS_WGU0 + (size_t)NGU * 1024 * 2;
constexpr size_t WS_WDN0 = WS_WGU1 + (size_t)NGU * 1024 * 2;
constexpr size_t WS_WDN1 = WS_WDN0 + (size_t)1024 * DFF * 2;
constexpr size_t WS_WQKV = WS_WDN1 + (size_t)1024 * DFF * 2;
constexpr size_t WS_WNAO = WS_WQKV + (size_t)NQKV * 1024 * 2;
constexpr size_t WS_R1 = 62914560;
static_assert(WS_WNAO + (size_t)1024 * 1024 * 2 <= WS_R1, "weights overflow");
constexpr size_t WS_Z = WS_R1;
constexpr size_t WS_XR = WS_Z + (size_t)T * 1024 * 2;
constexpr size_t WS_BCX = WS_XR + (size_t)T * 1536 * 2;
constexpr size_t WS_GU = WS_R1;
constexpr size_t WS_QKV = WS_R1;
constexpr size_t WS_YB = WS_XR;
constexpr size_t WS_YPART = WS_XR + (size_t)T * 1024 * 4;
static_assert(WS_YPART + (size_t)T * 1024 * 4 <= WS_BCX + (size_t)T * 3072 * 2, "SSD partials overflow R1");
constexpr size_t WS_XB = WS_R1 + 67108864;
constexpr size_t WS_R2 = WS_R1 + (size_t)T * 5632 * 2;
static_assert(WS_XB + (size_t)T * 1024 * 2 <= WS_R2 && (size_t)T * 3072 * 2 <= 67108864, "residual stream placement");
constexpr size_t WS_XC = WS_R2;
constexpr size_t WS_YCAT = WS_XC + (size_t)T * 1536 * 2;
constexpr size_t WS_H = WS_R2;
constexpr size_t WS_ACT = WS_R1;
constexpr size_t WS_ATT = WS_R2;
constexpr size_t WS_DTRAW = WS_YCAT + (size_t)T * 2048 * 2;
constexpr size_t WS_DT = WS_DTRAW + (size_t)T * 32 * 4;
constexpr size_t WS_HALO = WS_DT + (size_t)T * 32 * 4;
constexpr size_t WS_END = WS_HALO + (size_t)12 * 2816 * 4;
static_assert(WS_END <= 268435456ull, "workspace over 256 MiB");

constexpr size_t OUT_Y = 0, OUT_STATE = 10485760, OUT_K = 18874368, OUT_V = 27262976;

__device__ __forceinline__ unsigned f2bf(float f) { unsigned u = __builtin_bit_cast(unsigned, f); return (u + 0x7fffu + ((u >> 16) & 1u)) >> 16; }
__device__ __forceinline__ unsigned pk2(float lo, float hi) { unsigned r; asm("v_cvt_pk_bf16_f32 %0, %1, %2" : "=v"(r) : "v"(lo), "v"(hi)); return r; }
__device__ __forceinline__ float bflo(unsigned w) { return __builtin_bit_cast(float, w << 16); }
__device__ __forceinline__ float bfhi(unsigned w) { return __builtin_bit_cast(float, w & 0xffff0000u); }
__device__ __forceinline__ float bf1(bf16_t h) { return __builtin_bit_cast(float, ((unsigned)h) << 16); }
__device__ __forceinline__ float wave_sum(float v) {
#pragma unroll
    for (int o = 1; o < 64; o <<= 1) v += __shfl_xor(v, o);
    return v;
}
__device__ __forceinline__ float silu_f(float x) { return x * __builtin_amdgcn_rcpf(1.f + __builtin_amdgcn_exp2f(-1.4426950409f * x)); }
__device__ __forceinline__ float gelu_fast(float x) { const float t = x * (1.5957691216f + 0.0713548163f * x * x); return x * __builtin_amdgcn_rcpf(1.f + __builtin_amdgcn_exp2f(-1.4426950409f * t)); }
__device__ __forceinline__ float gelu_tanh_f(float x) {
    const float u = 0.7978845608028654f * (x + 0.044715f * x * x * x);
    const float e = __expf(-2.f * fabsf(u)); float th = (1.f - e) / (1.f + e); th = u < 0.f ? -th : th;
    return 0.5f * x * (1.f + th);
}
#define LDS_BARRIER() do { asm volatile("s_waitcnt lgkmcnt(0)" ::: "memory"); __builtin_amdgcn_s_barrier(); asm volatile("" ::: "memory"); } while (0)
#define MFMA16(a, b, c) __builtin_amdgcn_mfma_f32_16x16x32_bf16((a), (b), (c), 0, 0, 0)

namespace pg8 {
constexpr int BM = 256, BK = 64, HALF = 128, HTB = HALF * BK * 2, STAGE_BYTES = 8 * HTB, NXCD = 8, WGM = 8;
__host__ __device__ __forceinline__ int lds_byte(int r, int c) { const int st = (r >> 4) * 2 + (c >> 5), rr = r & 15, cc = c & 31, ob = rr * 64 + cc * 2; return st * 1024 + (ob ^ (((ob >> 9) & 1) << 5)); }
__host__ __device__ __forceinline__ void stage_rc(int b, int& R, int& C) { const int st = b / 1024, sb = b % 1024, swz = sb ^ (((sb >> 9) & 1) << 5); R = (st >> 1) * 16 + swz / 64; C = (st & 1) * 32 + (swz % 64) / 2; }
__host__ __device__ __forceinline__ int perm32(int rho) { const int n = rho >> 4, i = rho & 15; return 8 * (i >> 2) + 4 * n + (i & 3); }
struct Unit { int pm, pn; };
struct Gemm { const bf16_t* A; const bf16_t* Bt; int M, N, K; };
struct StaticOrder {
    int nM, nN, nwg, G, c;
    __device__ void init(int M, int N, int G_, int c_) { nM = M / BM; nN = N / BM; nwg = nM * nN; G = G_; c = c_; }
    __device__ bool next(int i, Unit& u) const {
        const long L = (long)i * G + c; if (L >= nwg) return false;
        int wgid = (int)L; { const int q = nwg / NXCD, r = nwg % NXCD, xcd = wgid % NXCD, off = wgid / NXCD; wgid = (xcd < r ? xcd * (q + 1) : r * (q + 1) + (xcd - r) * q) + off; }
        const int nig = WGM * nN, gid = wgid / nig, fm = gid * WGM, gsz = (nM - fm) < WGM ? (nM - fm) : WGM;
        u.pm = fm + ((wgid % nig) % gsz); u.pn = (wgid % nig) / gsz; return true;
    }
};
__device__ __forceinline__ unsigned cvt_pk_bf16(float lo, float hi) { unsigned r; asm volatile("v_cvt_pk_bf16_f32 %0, %1, %2" : "=v"(r) : "v"(lo), "v"(hi)); return r; }

__device__ __forceinline__ void store_bf16_tile(const f32x4 (&acc)[2][2][4][2], bf16_t* base, int ldc, int row0, int col0) {
#pragma unroll
    for (int ai = 0; ai < 2; ++ai)
#pragma unroll
        for (int m = 0; m < 4; ++m) { bf16_t* rowp = base + (size_t)(row0 + ai * HALF + m * 16) * ldc + col0;
#pragma unroll
            for (int bj = 0; bj < 2; ++bj) { const f32x4 v0 = acc[ai][bj][m][0], v1 = acc[ai][bj][m][1];
                u32x4 w; w.x = cvt_pk_bf16(v0[0], v0[1]); w.y = cvt_pk_bf16(v0[2], v0[3]); w.z = cvt_pk_bf16(v1[0], v1[1]); w.w = cvt_pk_bf16(v1[2], v1[3]);
                *(u32x4*)(rowp + bj * HALF) = w; } }
}
struct EpiIn {
    static constexpr bool PERM = true, ALIGN = false;
    bf16_t* Z; bf16_t* XR; bf16_t* BCX; float* DTRAW;
    __device__ __forceinline__ void operator()(const f32x4 (&acc)[2][2][4][2], const Unit& u, int wr, int wc, int fr, int fq) const {
        const int row0 = u.pm * BM + wr * 64 + fr;
        if (u.pn == 22) {
            if (wc == 0) {
#pragma unroll
                for (int ai = 0; ai < 2; ++ai)
#pragma unroll
                    for (int m = 0; m < 4; ++m) { float* p = DTRAW + (size_t)(row0 + ai * HALF + m * 16) * 32 + 8 * fq;
                        *(f32x4*)p = acc[ai][0][m][0]; *(f32x4*)(p + 4) = acc[ai][0][m][1]; }
            }
            return;
        }
        bf16_t* base; int ldc, colt;
        if (u.pn < 4) { base = Z; ldc = 1024; colt = u.pn * 256; } else if (u.pn < 10) { base = XR; ldc = 1536; colt = (u.pn - 4) * 256; } else { base = BCX; ldc = 3072; colt = (u.pn - 10) * 256; }
        store_bf16_tile(acc, base, ldc, row0, colt + wc * 32 + 8 * fq);
    }
};
struct EpiBf {
    static constexpr bool PERM = true, ALIGN = false;
    bf16_t* O; int ldc;
    __device__ __forceinline__ void operator()(const f32x4 (&acc)[2][2][4][2], const Unit& u, int wr, int wc, int fr, int fq) const {
        store_bf16_tile(acc, O, ldc, u.pm * BM + wr * 64 + fr, u.pn * BM + wc * 32 + 8 * fq);
    }
};
struct EpiQKV {
    static constexpr bool PERM = true, ALIGN = false;
    bf16_t* O; float* OK; float* OV;
    __device__ __forceinline__ void operator()(const f32x4 (&acc)[2][2][4][2], const Unit& u, int wr, int wc, int fr, int fq) const {
        const int row0 = u.pm * BM + wr * 64 + fr, col0 = u.pn * BM + wc * 32 + 8 * fq;
        store_bf16_tile(acc, O, NQKV, row0, col0);
        if (u.pm < 32 && u.pn >= 4) {
            float* base = (u.pn < 8) ? (OK + (col0 - 1024)) : (OV + (col0 - 2048));
#pragma unroll
            for (int ai = 0; ai < 2; ++ai)
#pragma unroll
                for (int m = 0; m < 4; ++m) { float* rowp = base + (size_t)(row0 + ai * HALF + m * 16) * 1024;
#pragma unroll
                    for (int bj = 0; bj < 2; ++bj) { *(f32x4*)(rowp + bj * HALF) = acc[ai][bj][m][0]; *(f32x4*)(rowp + bj * HALF + 4) = acc[ai][bj][m][1]; } }
        }
    }
};
struct EpiRes {
    static constexpr bool PERM = false, ALIGN = false;
    const float* base_lo; const float* base_hi; float* out; const float* gate;
    __device__ __forceinline__ void operator()(const f32x4 (&acc)[2][2][4][2], const Unit& u, int wr, int wc, int fr, int fq) const {
        const int row0 = u.pm * BM + wr * 64 + fr, col0 = u.pn * BM + wc * 32 + 4 * fq;
        const int v = u.pm < 32 ? 0 : 1 + ((u.pm - 32) >> 2);
        const float* gv = gate + v * 6144 + col0;
        f32x4 g[2][2];
#pragma unroll
        for (int bj = 0; bj < 2; ++bj)
#pragma unroll
            for (int n = 0; n < 2; ++n) g[bj][n] = *(const f32x4*)(gv + bj * HALF + n * 16);
        const float* base = u.pm < 32 ? base_lo : base_hi;
        f32x4 bb[2][2][2][2];
#define EPIRES_LOAD(buf, gi) do { _Pragma("unroll") for (int mm = 0; mm < 2; ++mm) { const size_t off_ = (size_t)(row0 + ((gi) >> 1) * HALF + (2 * ((gi) & 1) + mm) * 16) * 1024 + col0; \
            _Pragma("unroll") for (int bj = 0; bj < 2; ++bj) _Pragma("unroll") for (int n = 0; n < 2; ++n) bb[buf][mm][bj][n] = *(const f32x4*)(base + off_ + bj * HALF + n * 16); } } while (0)
        EPIRES_LOAD(0, 0);
#pragma unroll
        for (int gi = 0; gi < 4; ++gi) {
            if (gi < 3) EPIRES_LOAD((gi + 1) & 1, gi + 1);
#pragma unroll
            for (int mm = 0; mm < 2; ++mm) { const int ai = gi >> 1, m = 2 * (gi & 1) + mm; const size_t off = (size_t)(row0 + ai * HALF + m * 16) * 1024 + col0;
#pragma unroll
                for (int bj = 0; bj < 2; ++bj)
#pragma unroll
                    for (int n = 0; n < 2; ++n) *(f32x4*)(out + off + bj * HALF + n * 16) = bb[gi & 1][mm][bj][n] + g[bj][n] * acc[ai][bj][m][n]; }
        }
#undef EPIRES_LOAD
    }
};

__device__ __forceinline__ f32x4 dpp_ror1(f32x4 v) { f32x4 r;
#pragma unroll
    for (int e = 0; e < 4; ++e) { const float x = v[e]; r[e] = __int_as_float(__builtin_amdgcn_update_dpp(0, __float_as_int(x), 0x121, 0xf, 0xf, false)); }
    return r; }
__device__ __forceinline__ f32x4 dpp_ror15(f32x4 v) { f32x4 r;
#pragma unroll
    for (int e = 0; e < 4; ++e) { const float x = v[e]; r[e] = __int_as_float(__builtin_amdgcn_update_dpp(0, __float_as_int(x), 0x12f, 0xf, 0xf, false)); }
    return r; }
struct EpiGUF {
    static constexpr bool PERM = true, ALIGN = true;
    bf16_t* ACTp; const float* fw; const float* HALO; LAS float* X;
    __device__ __forceinline__ void operator()(const f32x4 (&acc)[2][2][4][2], const Unit& u, int wr, int wc, int fr, int fq) const {
        const int cl = wc * 32 + 8 * fq;
        const int gc0 = u.pn * 128 + cl;
        f32x4 w0[2], w1[2], w2[2];
#pragma unroll
        for (int n = 0; n < 2; ++n) { w0[n] = *(const f32x4*)(fw + gc0 + 4 * n); w1[n] = *(const f32x4*)(fw + DFF + gc0 + 4 * n); w2[n] = *(const f32x4*)(fw + 2 * DFF + gc0 + 4 * n); }
        f32x4 hu[2], hd[2];
        {
            const f32x4 z = {0.f, 0.f, 0.f, 0.f};
            const bool lat = u.pm >= 32; const int q = (u.pm - 32) & 3, sq = (u.pm - 32) >> 2;
            const bool hasu = lat && q > 0, hasd = lat && q < 3;
            const float* pu = HALO + (size_t)(sq * 6 + 2 * (q - 1)) * DFF + gc0; const float* pd = HALO + (size_t)(sq * 6 + 2 * q + 1) * DFF + gc0;
#pragma unroll
            for (int n = 0; n < 2; ++n) { hu[n] = hasu ? *(const f32x4*)(pu + 4 * n) : z; hd[n] = hasd ? *(const f32x4*)(pd + 4 * n) : z; }
        }
#pragma unroll
        for (int ai = 0; ai < 2; ++ai) { const int rb = 2 * ai + wr;
            if (fr == 0) {
#pragma unroll
                for (int n = 0; n < 2; ++n) *(LAS f32x4*)(X + (rb * 2 + 0) * 128 + cl + 4 * n) = acc[ai][0][0][n]; }
            if (fr == 15) {
#pragma unroll
                for (int n = 0; n < 2; ++n) *(LAS f32x4*)(X + (rb * 2 + 1) * 128 + cl + 4 * n) = acc[ai][0][3][n]; } }
        asm volatile("s_waitcnt lgkmcnt(0)" ::: "memory"); __builtin_amdgcn_s_barrier(); asm volatile("" ::: "memory");
#pragma unroll
        for (int ai = 0; ai < 2; ++ai) { const int rb = 2 * ai + wr;
            f32x4 ux[2], dx[2];
#pragma unroll
            for (int n = 0; n < 2; ++n) {
                ux[n] = rb > 0 ? *(const LAS f32x4*)(X + ((rb - 1) * 2 + 1) * 128 + cl + 4 * n) : hu[n];
                dx[n] = rb < 3 ? *(const LAS f32x4*)(X + ((rb + 1) * 2 + 0) * 128 + cl + 4 * n) : hd[n]; }
#pragma unroll
            for (int m = 0; m < 4; ++m) {
                u32x4 o;
#pragma unroll
                for (int n = 0; n < 2; ++n) {
                    const f32x4 g = acc[ai][0][m][n];
                    const f32x4 tu = dpp_ror1(g), td = dpp_ror15(g);
                    f32x4 eu, ed;
                    if (m > 0) eu = dpp_ror1(acc[ai][0][m > 0 ? m - 1 : 0][n]); else eu = ux[n];
                    if (m < 3) ed = dpp_ror15(acc[ai][0][m < 3 ? m + 1 : 3][n]); else ed = dx[n];
                    f32x4 a;
#pragma unroll
                    for (int e = 0; e < 4; ++e) { const float up = fr > 0 ? tu[e] : eu[e], dn = fr < 15 ? td[e] : ed[e];
                        a[e] = gelu_fast(w0[n][e] * up + w1[n][e] * g[e] + w2[n][e] * dn) * acc[ai][1][m][n][e]; }
                    if (n == 0) { o.x = cvt_pk_bf16(a[0], a[1]); o.y = cvt_pk_bf16(a[2], a[3]); } else { o.z = cvt_pk_bf16(a[0], a[1]); o.w = cvt_pk_bf16(a[2], a[3]); }
                }
                *(u32x4*)(ACTp + (size_t)(u.pm * BM + ai * HALF + wr * 64 + m * 16 + fr) * DFF + gc0) = o;
            }
        }
    }
};

template <bool SRCF32> struct EpiResB {
    static constexpr bool PERM = true, ALIGN = false;
    const float* base_lo; const float* base_hi; const bf16_t* baseb; bf16_t* outb; const float* gate;
    __device__ __forceinline__ void operator()(const f32x4 (&acc)[2][2][4][2], const Unit& u, int wr, int wc, int fr, int fq) const {
        const int row0 = u.pm * BM + wr * 64 + fr, col0 = u.pn * BM + wc * 32 + 8 * fq;
        const int v = u.pm < 32 ? 0 : 1 + ((u.pm - 32) >> 2);
        const float* gv = gate + v * 6144 + col0;
        f32x4 g[2][2];
#pragma unroll
        for (int bj = 0; bj < 2; ++bj)
#pragma unroll
            for (int n = 0; n < 2; ++n) g[bj][n] = *(const f32x4*)(gv + bj * HALF + 4 * n);
        const float* basef = u.pm < 32 ? base_lo : base_hi;
        f32x4 bf_[2][2][2][2]; u32x4 bh_[2][2][2];
#define EPIRB_LOAD(buf, gi) do { _Pragma("unroll") for (int mm = 0; mm < 2; ++mm) { const size_t off_ = (size_t)(row0 + ((gi) >> 1) * HALF + (2 * ((gi) & 1) + mm) * 16) * 1024 + col0; \
            _Pragma("unroll") for (int bj = 0; bj < 2; ++bj) { if (SRCF32) { bf_[buf][mm][bj][0] = *(const f32x4*)(basef + off_ + bj * HALF); bf_[buf][mm][bj][1] = *(const f32x4*)(basef + off_ + bj * HALF + 4); } \
                else bh_[buf][mm][bj] = *(const u32x4*)(baseb + off_ + bj * HALF); } } } while (0)
        EPIRB_LOAD(0, 0);
#pragma unroll
        for (int gi = 0; gi < 4; ++gi) {
            if (gi < 3) EPIRB_LOAD((gi + 1) & 1, gi + 1);
#pragma unroll
            for (int mm = 0; mm < 2; ++mm) { const int ai = gi >> 1, m = 2 * (gi & 1) + mm; const size_t off = (size_t)(row0 + ai * HALF + m * 16) * 1024 + col0;
#pragma unroll
                for (int bj = 0; bj < 2; ++bj) {
                    f32x4 b0, b1;
                    if (SRCF32) { b0 = bf_[gi & 1][mm][bj][0]; b1 = bf_[gi & 1][mm][bj][1]; }
                    else { const u32x4 h = bh_[gi & 1][mm][bj]; b0 = (f32x4){bflo(h.x), bfhi(h.x), bflo(h.y), bfhi(h.y)}; b1 = (f32x4){bflo(h.z), bfhi(h.z), bflo(h.w), bfhi(h.w)}; }
                    const f32x4 x0 = b0 + g[bj][0] * acc[ai][bj][m][0], x1 = b1 + g[bj][1] * acc[ai][bj][m][1];
                    u32x4 w; w.x = cvt_pk_bf16(x0[0], x0[1]); w.y = cvt_pk_bf16(x0[2], x0[3]); w.z = cvt_pk_bf16(x1[0], x1[1]); w.w = cvt_pk_bf16(x1[2], x1[3]);
                    *(u32x4*)(outb + off + bj * HALF) = w; } }
        }
#undef EPIRB_LOAD
    }
};

template <class Epi>
__device__ __forceinline__ void gemm_phase(LAS unsigned char* lds, const Gemm g, const StaticOrder& S, const Epi& E) {
    int tid_ = threadIdx.x; asm volatile("" : "+v"(tid_));
    const int tid = tid_, wid = __builtin_amdgcn_readfirstlane(tid >> 6), lane = tid & 63, wr = wid >> 2, wc = wid & 3, fr = lane & 15, fq = lane >> 4;
    const int K = g.K, nt = K / BK;
    unsigned voffA[2], voffB[2];
#pragma unroll
    for (int i = 0; i < 2; ++i) { int R, C; stage_rc(tid * 16 + i * 8192, R, C); const int Rb = Epi::PERM ? ((R & ~31) + perm32(R & 31)) : R;
        voffA[i] = (unsigned)(R * K + C) * 2u; voffB[i] = (unsigned)(Rb * K + C) * 2u; }
    const size_t kstep = (size_t)(BK * 2);
    const size_t hstep = (size_t)HALF * K * 2;
    const size_t tstep = 2 * hstep;
    const unsigned ldsw = (unsigned)wid * 1024u;
    const int aoff = lds_byte(wr * 64 + fr, fq * 8), boff = lds_byte(wc * 32 + fr, fq * 8);
#define PG8_SA(b, h) (((b) * 2 + (h)) * HTB)
#define PG8_SB(b, h) ((4 + (b) * 2 + (h)) * HTB)
#define PG8_STAGE(bufoff, gbase, voff) do { _Pragma("unroll") for (int _i = 0; _i < 2; ++_i) \
        __builtin_amdgcn_global_load_lds((const unsigned*)((const char*)(gbase) + (voff)[_i]), (LAS unsigned*)(lds + (bufoff) + ldsw + _i * 8192), 16, 0, 0); } while (0)
#define PG8_LDA(dst, b, h) do { _Pragma("unroll") for (int m = 0; m < 4; ++m) _Pragma("unroll") for (int k = 0; k < 2; ++k) dst[m][k] = *(const LAS bf16x8*)(lds + PG8_SA(b, h) + aoff + m * 2048 + k * 1024); } while (0)
#define PG8_LDB(dst, b, h) do { _Pragma("unroll") for (int n = 0; n < 2; ++n) _Pragma("unroll") for (int k = 0; k < 2; ++k) dst[n][k] = *(const LAS bf16x8*)(lds + PG8_SB(b, h) + boff + n * 2048 + k * 1024); } while (0)
#define PG8_MMA(ai, bj, At, Bt) do { __builtin_amdgcn_s_setprio(1); _Pragma("unroll") for (int m = 0; m < 4; ++m) _Pragma("unroll") for (int n = 0; n < 2; ++n) _Pragma("unroll") for (int k = 0; k < 2; ++k) \
        acc[ai][bj][m][n] = __builtin_amdgcn_mfma_f32_16x16x32_bf16(Bt[n][k], At[m][k], acc[ai][bj][m][n], 0, 0, 0); __builtin_amdgcn_s_setprio(0); } while (0)
#define PG8_WAIT_V(n) asm volatile("s_waitcnt vmcnt(" #n ")" ::: "memory")
#define PG8_WAIT_L(n) asm volatile("s_waitcnt lgkmcnt(" #n ")" ::: "memory")
#define PG8_BAR __builtin_amdgcn_s_barrier()
#define PG8_SCHED __builtin_amdgcn_sched_barrier(0)
    Unit cur, nxt; int ui = 0;
    if (!S.next(0, cur)) return;
    if (S.nwg > S.G) {
        const int rounds = (S.nwg + S.G - 1) / S.G;
        if ((long)(rounds - 1) * S.G + S.c >= S.nwg) { for (int i = 0; i < 3; ++i) __builtin_amdgcn_s_sleep(127); }
    }
    f32x4 acc[2][2][4][2];
#pragma unroll
    for (int a = 0; a < 2; ++a)
#pragma unroll
        for (int b = 0; b < 2; ++b)
#pragma unroll
            for (int m = 0; m < 4; ++m)
#pragma unroll
                for (int n = 0; n < 2; ++n) acc[a][b][m][n] = (f32x4){0.f, 0.f, 0.f, 0.f};
    bf16x8 At[4][2], B0[2][2], B1[2][2];
    const char* cA = (const char*)g.A + (size_t)cur.pm * tstep; const char* cB = (const char*)g.Bt + (size_t)cur.pn * tstep;
    PG8_STAGE(PG8_SB(0, 0), cB, voffB); PG8_STAGE(PG8_SA(0, 0), cA, voffA); PG8_STAGE(PG8_SB(0, 1), cB + hstep, voffB); PG8_STAGE(PG8_SA(0, 1), cA + hstep, voffA);
    if (wr == 1) PG8_BAR;
    PG8_WAIT_V(4); PG8_BAR;
    PG8_STAGE(PG8_SB(1, 0), cB + kstep, voffB); PG8_STAGE(PG8_SA(1, 0), cA + kstep, voffA); PG8_STAGE(PG8_SB(1, 1), cB + hstep + kstep, voffB);
    PG8_WAIT_V(6); PG8_BAR;
    for (;;) {
        const bool has_next = S.next(ui + 1, nxt);
        const char* nA = has_next ? (const char*)g.A + (size_t)nxt.pm * tstep : cA; const char* nB = has_next ? (const char*)g.Bt + (size_t)nxt.pn * tstep : cB;
        for (int t = 0; t < nt; t += 2) {
            const bool last = (t == nt - 2);
            const char* a1 = cA + (size_t)(t + 1) * kstep;
            const char* a2 = last ? nA : cA + (size_t)(t + 2) * kstep; const char* b2 = last ? nB : cB + (size_t)(t + 2) * kstep;
            const char* a3 = a2 + kstep; const char* b3 = b2 + kstep;
            PG8_LDB(B0, 0, 0); PG8_SCHED; PG8_LDA(At, 0, 0); PG8_STAGE(PG8_SA(1, 1), a1 + hstep, voffA);
            PG8_WAIT_L(8); PG8_BAR; PG8_WAIT_L(0); PG8_MMA(0, 0, At, B0); PG8_BAR; PG8_SCHED;
            PG8_LDB(B1, 0, 1); PG8_STAGE(PG8_SB(0, 0), b2, voffB);
            PG8_BAR; PG8_WAIT_L(0); PG8_MMA(0, 1, At, B1); PG8_BAR;
            PG8_LDA(At, 0, 1); PG8_STAGE(PG8_SA(0, 0), a2, voffA);
            PG8_BAR; PG8_WAIT_L(0); PG8_MMA(1, 0, At, B0); PG8_BAR; PG8_SCHED;
            PG8_STAGE(PG8_SB(0, 1), b2 + hstep, voffB);
            PG8_WAIT_V(6); PG8_BAR; PG8_MMA(1, 1, At, B1); PG8_BAR;
            PG8_LDB(B0, 1, 0); PG8_SCHED; PG8_LDA(At, 1, 0); PG8_STAGE(PG8_SA(0, 1), a2 + hstep, voffA);
            PG8_WAIT_L(8); PG8_BAR; PG8_WAIT_L(0); PG8_MMA(0, 0, At, B0); PG8_BAR; PG8_SCHED;
            PG8_LDB(B1, 1, 1); PG8_STAGE(PG8_SB(1, 0), b3, voffB);
            PG8_BAR; PG8_WAIT_L(0); PG8_MMA(0, 1, At, B1); PG8_BAR;
            PG8_LDA(At, 1, 1); PG8_STAGE(PG8_SA(1, 0), a3, voffA);
            PG8_BAR; PG8_WAIT_L(0); PG8_MMA(1, 0, At, B0); PG8_BAR; PG8_SCHED;
            PG8_STAGE(PG8_SB(1, 1), b3 + hstep, voffB);
            PG8_WAIT_V(6); PG8_BAR; PG8_MMA(1, 1, At, B1); PG8_BAR;
        }
        if constexpr (Epi::ALIGN) { if (wr == 0) PG8_BAR; }
        E(acc, cur, wr, wc, fr, fq);
        if (!has_next) break;
#pragma unroll
        for (int a = 0; a < 2; ++a)
#pragma unroll
            for (int b = 0; b < 2; ++b)
#pragma unroll
                for (int m = 0; m < 4; ++m)
#pragma unroll
                    for (int n = 0; n < 2; ++n) acc[a][b][m][n] = (f32x4){0.f, 0.f, 0.f, 0.f};
        cur = nxt; cA = nA; cB = nB; ++ui;
        if constexpr (Epi::ALIGN) { if (wr == 1) PG8_BAR; }
    }
    PG8_WAIT_V(0);
    if constexpr (!Epi::ALIGN) { if (wr == 0) PG8_BAR; }
    PG8_BAR;
#undef PG8_SA
#undef PG8_SB
#undef PG8_STAGE
#undef PG8_LDA
#undef PG8_LDB
#undef PG8_MMA
#undef PG8_WAIT_V
#undef PG8_WAIT_L
#undef PG8_BAR
#undef PG8_SCHED
}
}

__device__ __forceinline__ f32x4 bf4_to_f32(u32x2 h) { return (f32x4){bflo(h.x), bfhi(h.x), bflo(h.y), bfhi(h.y)}; }
__device__ __forceinline__ void norm_rows(int r0, int r1, const float* x_lo_, const float* x_hi_, const bf16_t* xb, const float* g, const float* modv, int sh_off, bf16_t* O, float* Of, int lane) {
    int curv = -1; f32x4 gs[4], shv[4], nx[4];
#pragma unroll
    for (int j = 0; j < 4; ++j) nx[j] = (f32x4){0.f, 0.f, 0.f, 0.f};
    if (r0 < r1) {
        if (xb) { const u32x2* xn = (const u32x2*)(xb + (size_t)r0 * 1024) + lane;
#pragma unroll
            for (int j = 0; j < 4; ++j) nx[j] = bf4_to_f32(xn[64 * j]); }
        else { const f32x4* xn = (const f32x4*)((r0 < T_CTX ? x_lo_ : x_hi_) + (size_t)r0 * 1024) + lane;
#pragma unroll
            for (int j = 0; j < 4; ++j) nx[j] = xn[64 * j]; } }
    for (int m = r0; m < r1; ++m) {
        const int v = m < T_CTX ? 0 : 1 + ((m - T_CTX) >> 10);
        if (v != curv) { curv = v;
#pragma unroll
            for (int j = 0; j < 4; ++j) { const f32x4 gg = ((const f32x4*)g)[lane + 64 * j];
                if (modv) { const f32x4 a = ((const f32x4*)(modv + v * 6144 + sh_off + 1024))[lane + 64 * j]; gs[j] = gg * (a + 1.f); shv[j] = ((const f32x4*)(modv + v * 6144 + sh_off))[lane + 64 * j]; }
                else { gs[j] = gg; shv[j] = (f32x4){0.f, 0.f, 0.f, 0.f}; } } }
        f32x4 vv[4]; float s = 0.f;
#pragma unroll
        for (int j = 0; j < 4; ++j) { vv[j] = nx[j]; s += (vv[j].x * vv[j].x + vv[j].y * vv[j].y) + (vv[j].z * vv[j].z + vv[j].w * vv[j].w); }
        if (m + 1 < r1) {
            if (xb) { const u32x2* xn = (const u32x2*)(xb + (size_t)(m + 1) * 1024) + lane;
#pragma unroll
                for (int j = 0; j < 4; ++j) nx[j] = bf4_to_f32(xn[64 * j]); }
            else { const f32x4* xn = (const f32x4*)((m + 1 < T_CTX ? x_lo_ : x_hi_) + (size_t)(m + 1) * 1024) + lane;
#pragma unroll
                for (int j = 0; j < 4; ++j) nx[j] = xn[64 * j]; } }
        const float rstd = 1.f / sqrtf(wave_sum(s) * (1.f / 1024.f) + 1e-6f);
#pragma unroll
        for (int j = 0; j < 4; ++j) { const f32x4 y = vv[j] * rstd * gs[j] + shv[j];
            if (modv) { u32x2 wv; wv.x = pk2(y.x, y.y); wv.y = pk2(y.z, y.w); ((u32x2*)(O + (size_t)m * 1024))[lane + 64 * j] = wv; }
            else ((f32x4*)(Of + (size_t)m * 1024))[lane + 64 * j] = y; }
    }
}

#define XB_TMO      128
#define XB_XCNT(j)  (256  + 64 * (j))
#define XB_XSUB(j)  (1280 + 64 * (j))
#define XB_XGEN(j)  (2304 + 64 * (j))
#define XB_TOP      3328
#define XB_TOPGEN   3392
#define XCD_BAR_WORDS 3456
#define XB_SPIN_CAP (1u << 18)
__device__ __forceinline__ unsigned xb_ld(unsigned* p)              { return __hip_atomic_load(p, __ATOMIC_RELAXED, __HIP_MEMORY_SCOPE_AGENT); }
__device__ __forceinline__ unsigned xb_add(unsigned* p, unsigned v) { return __hip_atomic_fetch_add(p, v, __ATOMIC_RELAXED, __HIP_MEMORY_SCOPE_AGENT); }
__device__ __forceinline__ unsigned xb_xcc_id() { return (unsigned)__builtin_amdgcn_s_getreg((3 << 11) | 20) & 0xFu; }
#define XB_SPIN(cond, bar) do { unsigned _sp = 0; while (cond) { __builtin_amdgcn_s_sleep(1); \
    if ((++_sp & 255u) == 0u) { if (xb_ld(&(bar)[XB_TMO])) break; if (_sp > XB_SPIN_CAP) { atomicAdd(&(bar)[XB_TMO], 1u); break; } } } } while (0)
__device__ __forceinline__ void xcd_barrier_complete(unsigned* bar, unsigned x, unsigned& nloc, unsigned& nx) {
    const unsigned G = gridDim.x * gridDim.y * gridDim.z;
    unsigned sum, cnt, mine, sp = 0u;
    for (;;) {
        sum = 0u; cnt = 0u; mine = 0u;
#pragma unroll
        for (unsigned j = 0; j < 16; ++j) { const unsigned c = xb_ld(&bar[XB_XCNT(j)]); sum += c; cnt += (c > 0u) ? 1u : 0u; mine = (j == x) ? c : mine; }
        if (sum == G) break;
        __builtin_amdgcn_s_sleep(1);
        if ((++sp & 255u) == 0u) { if (xb_ld(&bar[XB_TMO])) break; if (sp > XB_SPIN_CAP) { atomicAdd(&bar[XB_TMO], 1u); break; } }
    }
    nloc = mine > 0u ? mine : 1u; nx = cnt > 0u ? cnt : 1u;
}
__device__ __forceinline__ void xcd_barrier(unsigned* bar, volatile LAS unsigned* st) {
    asm volatile("s_waitcnt vmcnt(0)" ::: "memory");
    __syncthreads();
    if (threadIdx.x == 0) {
        const unsigned x = xb_xcc_id();
        __builtin_amdgcn_s_waitcnt(0);
        unsigned nloc = st[0], nx = st[1];
        if (nloc == 0u) { xcd_barrier_complete(bar, x, nloc, nx); st[0] = nloc; st[1] = nx; }
        const unsigned old = xb_add(&bar[XB_XSUB(x)], 1u);
        const unsigned gen = old / nloc;
        if (old + 1u == (gen + 1u) * nloc) {
            __builtin_amdgcn_fence(__ATOMIC_RELEASE, "agent");
            asm volatile("s_waitcnt vmcnt(0)" ::: "memory");
            const unsigned og = xb_add(&bar[XB_TOP], 1u);
            const unsigned tg = og / nx;
            if (og + 1u == (tg + 1u) * nx) xb_add(&bar[XB_TOPGEN], 1u);
            else XB_SPIN(xb_ld(&bar[XB_TOPGEN]) == tg, bar);
            __builtin_amdgcn_fence(__ATOMIC_ACQUIRE, "agent");
            xb_add(&bar[XB_XGEN(x)], 1u);
            asm volatile("s_waitcnt vmcnt(0)" ::: "memory");
        } else {
            XB_SPIN(xb_ld(&bar[XB_XGEN(x)]) == gen, bar);
            __builtin_amdgcn_fence(__ATOMIC_ACQUIRE, "agent");
            asm volatile("s_waitcnt vmcnt(0)" ::: "memory");
        }
    }
    __syncthreads();
}

struct Args {
    const float* in[28];
    float* out; unsigned char* ws;
    int ph_lo, ph_hi;
};
enum { I_XP = 0, I_XS, I_STATE, I_CK, I_CV, I_C, I_CCTX, I_ADAW, I_ADAB, I_NMG, I_NFG, I_WIN, I_CONVW, I_CONVB, I_DTB, I_ALOG, I_DSK, I_SNG, I_SCW, I_WMO,
       I_WQKV, I_RPB, I_WNAO, I_WG, I_WU, I_FCW, I_WD, I_FNG };

__device__ __forceinline__ void transpose_item(const float* W, int K, int N, bf16_t* WT, int kind, LAS float* scr, int item, int lane) {
    const int nblk = N / 32, kb = item / nblk, nb = item % nblk, k0 = 64 * kb, n0 = 32 * nb;
    int r0;
    if (kind == 0) r0 = n0;
    else if (kind == 1) r0 = n0 < 2560 ? n0 : (n0 < 2592 ? n0 + 3072 : n0 - 32);
    else if (kind == 2) r0 = 256 * (n0 >> 7) + (n0 & 127);
    else r0 = 256 * (n0 >> 7) + 128 + (n0 & 127);
#pragma unroll 8
    for (int i = 0; i < 32; ++i) { const int kk = 2 * i + (lane >> 5); scr[kk * 33 + (lane & 31)] = W[(size_t)(k0 + kk) * N + n0 + (lane & 31)]; }
    asm volatile("s_waitcnt lgkmcnt(0)" ::: "memory");
    const int c = lane & 7;
#pragma unroll
    for (int j = 0; j < 4; ++j) { const int n = (lane >> 3) + 8 * j; const LAS float* s = scr + (8 * c) * 33 + n;
        u32x4 o; o.x = pk2(s[0 * 33], s[1 * 33]); o.y = pk2(s[2 * 33], s[3 * 33]); o.z = pk2(s[4 * 33], s[5 * 33]); o.w = pk2(s[6 * 33], s[7 * 33]);
        *(u32x4*)(WT + (size_t)(r0 + n) * K + k0 + 8 * c) = o; }
    asm volatile("s_waitcnt lgkmcnt(0)" ::: "memory");
}

__device__ __forceinline__ void norm_row(const float* xrow, const float* g, const float* sh, const float* sc, bf16_t* orow, float* orow_f32, int lane) {
    const f32x4* xr = (const f32x4*)xrow + lane;
    f32x4 v[4]; float s = 0.f;
#pragma unroll
    for (int j = 0; j < 4; ++j) { v[j] = xr[64 * j]; s += (v[j].x * v[j].x + v[j].y * v[j].y) + (v[j].z * v[j].z + v[j].w * v[j].w); }
    const float rstd = 1.f / sqrtf(wave_sum(s) * (1.f / 1024.f) + 1e-6f);
#pragma unroll
    for (int j = 0; j < 4; ++j) {
        const f32x4 gg = ((const f32x4*)g)[lane + 64 * j];
        f32x4 y = v[j] * rstd * gg;
        if (sc) { const f32x4 a = ((const f32x4*)sc)[lane + 64 * j], b = ((const f32x4*)sh)[lane + 64 * j]; y = y * (a + 1.f) + b;
            u32x2 w; w.x = pk2(y.x, y.y); w.y = pk2(y.z, y.w); ((u32x2*)orow)[lane + 64 * j] = w; }
        else ((f32x4*)orow_f32)[lane + 64 * j] = y;
    }
}

#ifndef PROBE_MASK
#define PROBE_MASK 0u
#endif
#define REP(k) for (int rep_ = 0; rep_ < ((((unsigned)PROBE_MASK >> (k)) & 1u) ? 2 : 1); ++rep_)
#ifndef SKIP_SSD
#define SKIP_SSD 0
#endif
#ifndef SKIP_ATT
#define SKIP_ATT 0
#endif
#ifndef SKIP_NA
#define SKIP_NA 0
#endif
#define PHASE_IDS() unsigned char* ws = args.ws; asm volatile("" : "+s"(ws)); int tid_ = threadIdx.x; asm volatile("" : "+v"(tid_)); const int tid = tid_, lane = tid & 63, wave = __builtin_amdgcn_readfirstlane(tid >> 6); \
    const int gw = bx * NWAVES + wave, NGW = G * NWAVES; const size_t gt = (size_t)bx * NTHREADS + tid, NGT = (size_t)G * NTHREADS; (void)lane; (void)gw; (void)NGW; (void)gt; (void)NGT;
#define PHASE_WS() unsigned char* ws = args.ws; asm volatile("" : "+s"(ws));
#define MOD ((float*)(ws + WS_MOD))
#define WIN ((bf16_t*)(ws + WS_WIN))
#define WMO ((bf16_t*)(ws + WS_WMO))
#define WQKV ((bf16_t*)(ws + WS_WQKV))
#define WNAO ((bf16_t*)(ws + WS_WNAO))
#define Zb ((bf16_t*)(ws + WS_Z))
#define XR ((bf16_t*)(ws + WS_XR))
#define BCX ((bf16_t*)(ws + WS_BCX))
#define GU ((bf16_t*)(ws + WS_GU))
#define QKV ((bf16_t*)(ws + WS_QKV))
#define YB ((bf16_t*)(ws + WS_YB))
#define YPART ((bf16_t*)(ws + WS_YPART))
#define XC ((bf16_t*)(ws + WS_XC))
#define YCAT ((bf16_t*)(ws + WS_YCAT))
#define Hb ((bf16_t*)(ws + WS_H))
#define ACT ((bf16_t*)(ws + WS_ACT))
#define ATT ((bf16_t*)(ws + WS_ATT))
#define DTRAW ((float*)(ws + WS_DTRAW))
#define DT ((float*)(ws + WS_DT))
#define OUTY (args.out + OUT_Y)
#define XB ((bf16_t*)(ws + WS_XB))
#define x_lo (args.in[I_XP])
#define x_hi (args.in[I_XS] - (size_t)T_CTX * 1024)
#define IN(k) (lo <= (k) && (k) < hi)
#define MISC_OFF (LDS_BYTES - 64)
#define SEAM(k) do { if (IN(k) && IN((k) + 1)) xcd_barrier((unsigned*)(args.ws + WS_BAR), (volatile LAS unsigned*)(lds + MISC_OFF)); } while (0)


__device__ __forceinline__ int mat_items(int id) { return id == 0 ? 16 * 177 : id == 1 ? 32 * 32 : id <= 5 ? 16 * 88 : id <= 7 ? 44 * 32 : id == 8 ? 16 * 96 : 16 * 32; }
__device__ __forceinline__ void mat_item(const Args& args, unsigned char* ws, int id, int r, LAS float* scr, int lane) {
    if (id == 0) transpose_item(args.in[I_WIN], 1024, NIN_SRC, (bf16_t*)(ws + WS_WIN), 1, scr, r, lane);
    else if (id == 1) transpose_item(args.in[I_WMO], 2048, 1024, (bf16_t*)(ws + WS_WMO), 0, scr, r, lane);
    else if (id <= 5) { const int q = id - 2, layer = q >> 1, up = q & 1;
        transpose_item(args.in[up ? I_WU : I_WG] + (size_t)layer * 1024 * DFF, 1024, DFF, (bf16_t*)(ws + (layer ? WS_WGU1 : WS_WGU0)), 2 + up, scr, r, lane); }
    else if (id <= 7) { const int layer = id - 6;
        transpose_item(args.in[I_WD] + (size_t)layer * DFF * 1024, DFF, 1024, (bf16_t*)(ws + (layer ? WS_WDN1 : WS_WDN0)), 0, scr, r, lane); }
    else if (id == 8) transpose_item(args.in[I_WQKV], 1024, NQKV, (bf16_t*)(ws + WS_WQKV), 0, scr, r, lane);
    else transpose_item(args.in[I_WNAO], 1024, 1024, (bf16_t*)(ws + WS_WNAO), 0, scr, r, lane);
}
template <int STAGE>
__device__ __forceinline__ void prep_stage(const Args& args, LAS unsigned char* lds, const int vb, const int nvb) {
    unsigned char* ws = args.ws; int tid_ = threadIdx.x; asm volatile("" : "+v"(tid_)); const int tid = tid_, lane = tid & 63, wave = __builtin_amdgcn_readfirstlane(tid >> 6);
    constexpr int ada_layer = STAGE == 0 ? 0 : (STAGE == 2 ? 1 : -1);
    if (ada_layer >= 0) {
        LAS float* sv = (LAS float*)lds;
        LAS float* red = (LAS float*)(lds + 12288);
        for (int i = tid; i < 3072; i += NTHREADS) { const int v = i >> 10, k = i & 1023; const float c = v == 0 ? args.in[I_CCTX][k] : args.in[I_C][(v - 1) * 1024 + k]; sv[i] = silu_f(c); }
        __syncthreads();
        for (int cc = vb; cc < 96; cc += nvb) {
            const int layer = ada_layer;
            const int sub = lane >> 4, c4 = (lane & 15) * 4;
            const float* wp = args.in[I_ADAW] + ((size_t)layer * 1024 + wave * 128 + sub) * 6144 + cc * 64 + c4;
            f32x4 a0 = {0.f, 0.f, 0.f, 0.f}, a1 = a0, a2 = a0;
#pragma unroll 8
            for (int it = 0; it < 32; ++it) { const f32x4 w4 = *(const f32x4*)(wp + (size_t)it * 4 * 6144); const int k = wave * 128 + it * 4 + sub;
                a0 += w4 * sv[k]; a1 += w4 * sv[1024 + k]; a2 += w4 * sv[2048 + k]; }
#pragma unroll
            for (int e = 0; e < 4; ++e) { a0[e] += __shfl_xor(a0[e], 16); a0[e] += __shfl_xor(a0[e], 32); a1[e] += __shfl_xor(a1[e], 16); a1[e] += __shfl_xor(a1[e], 32); a2[e] += __shfl_xor(a2[e], 16); a2[e] += __shfl_xor(a2[e], 32); }
            if (lane < 16) { *(LAS f32x4*)(red + (wave * 3 + 0) * 64 + c4) = a0; *(LAS f32x4*)(red + (wave * 3 + 1) * 64 + c4) = a1; *(LAS f32x4*)(red + (wave * 3 + 2) * 64 + c4) = a2; }
            __syncthreads();
            if (tid < 192) { const int v = tid >> 6, c = tid & 63; float s = args.in[I_ADAB][layer * 6144 + cc * 64 + c];
#pragma unroll
                for (int w = 0; w < 8; ++w) s += red[(w * 3 + v) * 64 + c];
                ((float*)(ws + WS_MOD))[(layer * 3 + v) * 6144 + cc * 64 + c] = s; }
            __syncthreads();
        }
    }
    LAS float* scr = (LAS float*)(lds + 32768 + wave * 8448);
    constexpr int NID = STAGE == 0 ? 2 : (STAGE == 1 ? 3 : 5);
    constexpr int IDS[3][5] = {{0, 1, 0, 0, 0}, {2, 3, 6, 0, 0}, {4, 5, 7, 8, 9}};
    int total = 0;
#pragma unroll
    for (int j = 0; j < NID; ++j) total += mat_items(IDS[STAGE][j]);
    for (int it = vb * NWAVES + wave; it < total; it += nvb * NWAVES) {
        int r = it;
#pragma unroll
        for (int j = 0; j < NID; ++j) { const int n = mat_items(IDS[STAGE][j]); if (r >= 0 && r < n) mat_item(args, ws, IDS[STAGE][j], r, scr, lane); r -= n; }
    }
    if (STAGE == 0) { u32x4* z = (u32x4*)((bf16_t*)(ws + WS_WIN) + (size_t)NIN_SRC * 1024); const size_t n16 = (size_t)(NIN - NIN_SRC) * 1024 * 2 / 16;
        for (size_t i = (size_t)vb * NTHREADS + tid; i < n16; i += (size_t)nvb * NTHREADS) z[i] = (u32x4){0u, 0u, 0u, 0u}; }
    __syncthreads();
}

template <int layer>
__device__ __forceinline__ void layer_body(const Args& args, LAS unsigned char* lds, cg::grid_group& grid, const int lo, const int hi) {
    const int G = gridDim.x, bx = blockIdx.x;
        const int pb = 1 + layer * 10;
#define modl (MOD + layer * 3 * 6144)
        REP(pb) if (IN(pb)) {
            PHASE_IDS();
            const float* g = args.in[I_NMG] + layer * 1024;
            { const int rpw = (T + NGW - 1) / NGW, r0 = gw * rpw, r1 = min(T, r0 + rpw);
              norm_rows(r0, r1, x_lo, x_hi, layer == 0 ? (const bf16_t*)nullptr : (const bf16_t*)XB, g, modl, 0, Hb, nullptr, lane); }
        }
        SEAM(pb);
        if constexpr (layer == 0) {
            if (IN(2)) { PHASE_WS(); pg8::Gemm g{Hb, WIN, T, NIN, 1024}; pg8::StaticOrder S; S.init(T, NIN, G, bx); pg8::EpiIn E{Zb, XR, BCX, DTRAW}; pg8::gemm_phase(lds, g, S, E); }
            if constexpr (false) {}
            if ((((unsigned)PROBE_MASK >> (2)) & 1u)) if (IN(2)) { PHASE_WS(); pg8::Gemm g{Hb, WIN, T, NIN, 1024}; pg8::StaticOrder S; S.init(T, NIN, G, bx); pg8::EpiIn E{Zb, XR, BCX, DTRAW}; pg8::gemm_phase(lds, g, S, E); }
            SEAM(2);
            REP(3) if (IN(3)) {
                PHASE_IDS();
                const float* cw = args.in[I_CONVW]; const float* cb = args.in[I_CONVB]; const float* scw = args.in[I_SCW]; const float* dtb = args.in[I_DTB];
                const int ntask = (T / 8) * 320;
                for (int idx = (int)gt; idx < ntask; idx += (int)NGT) {
                    const int rbk = idx / 320, j = idx % 320, t0 = rbk * 8;
                    const int pos0 = t0 < T_CTX ? (t0 & 255) : ((t0 - T_CTX) & 1023), len = t0 < T_CTX ? 256 : 1024;
                    const bool hp = pos0 > 0, hn = pos0 + 8 < len;
                    const u32x4 z4 = {0u, 0u, 0u, 0u};
                    if (j < 192) {
                        const int c0 = 8 * j; const bf16_t* p = XR + (size_t)t0 * 1536 + c0;
                        float wa[8], wb[8], wc_[8], bb[8];
#pragma unroll
                        for (int q = 0; q < 2; ++q) { const f32x4 t0_ = *(const f32x4*)(cw + c0 + 4 * q), t1_ = *(const f32x4*)(cw + 1536 + c0 + 4 * q), t2_ = *(const f32x4*)(cw + 3072 + c0 + 4 * q), t3_ = *(const f32x4*)(cb + c0 + 4 * q);
#pragma unroll
                            for (int e = 0; e < 4; ++e) { wa[4 * q + e] = t0_[e]; wb[4 * q + e] = t1_[e]; wc_[4 * q + e] = t2_[e]; bb[4 * q + e] = t3_[e]; } }
                        u32x4 vr[10];
                        vr[0] = hp ? *(const u32x4*)(p - 1536) : z4;
#pragma unroll
                        for (int r = 0; r < 8; ++r) vr[r + 1] = *(const u32x4*)(p + (size_t)r * 1536);
                        vr[9] = hn ? *(const u32x4*)(p + (size_t)8 * 1536) : z4;
#pragma unroll
                        for (int r = 0; r < 8; ++r) {
                            const u32x4 vm = vr[r], v0 = vr[r + 1], vp = vr[r + 2];
                            float o[8];
#pragma unroll
                            for (int e = 0; e < 4; ++e) {
                                o[2 * e] = silu_f(wa[2 * e] * bflo(vm[e]) + wb[2 * e] * bflo(v0[e]) + wc_[2 * e] * bflo(vp[e]) + bb[2 * e]);
                                o[2 * e + 1] = silu_f(wa[2 * e + 1] * bfhi(vm[e]) + wb[2 * e + 1] * bfhi(v0[e]) + wc_[2 * e + 1] * bfhi(vp[e]) + bb[2 * e + 1]); }
                            u32x4 w; w.x = pk2(o[0], o[1]); w.y = pk2(o[2], o[3]); w.z = pk2(o[4], o[5]); w.w = pk2(o[6], o[7]);
                            *(u32x4*)(XC + (size_t)(t0 + r) * 1536 + c0) = w;
                        }
                    } else {
                        const int c0 = 8 * (j - 192); const bf16_t* p = BCX + (size_t)t0 * 3072 + c0;
                        float wa[8], wb[8], wc_[8];
#pragma unroll
                        for (int q = 0; q < 2; ++q) { const f32x4 t0_ = *(const f32x4*)(scw + c0 + 4 * q), t1_ = *(const f32x4*)(scw + 1024 + c0 + 4 * q), t2_ = *(const f32x4*)(scw + 2048 + c0 + 4 * q);
#pragma unroll
                            for (int e = 0; e < 4; ++e) { wa[4 * q + e] = t0_[e]; wb[4 * q + e] = t1_[e]; wc_[4 * q + e] = t2_[e]; } }
#pragma unroll
                        for (int hf = 0; hf < 2; ++hf) {
                            u32x4 cr[6], xr_[6], bgr[4];
#pragma unroll
                            for (int k = 0; k < 6; ++k) { const int rr = 4 * hf - 1 + k; const bool ok = (rr >= 0 || hp) && (rr <= 7 || hn);
                                cr[k] = ok ? *(const u32x4*)(p + (ptrdiff_t)rr * 3072 + 1024) : z4; xr_[k] = ok ? *(const u32x4*)(p + (ptrdiff_t)rr * 3072 + 2048) : z4; }
#pragma unroll
                            for (int k = 0; k < 4; ++k) bgr[k] = *(const u32x4*)(p + (size_t)(4 * hf + k) * 3072);
                            float pr[6][8];
#pragma unroll
                            for (int k = 0; k < 6; ++k)
#pragma unroll
                                for (int e = 0; e < 4; ++e) { pr[k][2 * e] = bflo(cr[k][e]) * bflo(xr_[k][e]); pr[k][2 * e + 1] = bfhi(cr[k][e]) * bfhi(xr_[k][e]); }
#pragma unroll
                            for (int k = 0; k < 4; ++k) {
                                float o[8];
#pragma unroll
                                for (int e = 0; e < 4; ++e) {
                                    o[2 * e] = bflo(bgr[k][e]) * (wa[2 * e] * pr[k][2 * e] + wb[2 * e] * pr[k + 1][2 * e] + wc_[2 * e] * pr[k + 2][2 * e]);
                                    o[2 * e + 1] = bfhi(bgr[k][e]) * (wa[2 * e + 1] * pr[k][2 * e + 1] + wb[2 * e + 1] * pr[k + 1][2 * e + 1] + wc_[2 * e + 1] * pr[k + 2][2 * e + 1]); }
                                u32x4 w; w.x = pk2(o[0], o[1]); w.y = pk2(o[2], o[3]); w.z = pk2(o[4], o[5]); w.w = pk2(o[6], o[7]);
                                *(u32x4*)(YCAT + (size_t)(t0 + 4 * hf + k) * 2048 + 1024 + c0) = w;
                            }
                        }
                    }
                }
                for (size_t idx = gt; idx < (size_t)T * 8; idx += NGT) {
                    const f32x4 r_ = *(const f32x4*)(DTRAW + idx * 4), b_ = *(const f32x4*)(dtb + (idx & 7) * 4); f32x4 d_;
#pragma unroll
                    for (int e = 0; e < 4; ++e) { const float xv = r_[e] + b_[e]; d_[e] = xv > 20.f ? xv : log1pf(expf(xv)); }
                    *(f32x4*)(DT + idx * 4) = d_;
                }
            }
            SEAM(3);
            REP(4)
            if (IN(4) && !SKIP_SSD) {
                PHASE_IDS();
                constexpr int LS = 136;
                LAS bf16_t* sC = (LAS bf16_t*)lds;
                LAS bf16_t* sB = (LAS bf16_t*)(lds + 34816);
                LAS bf16_t* sBt = (LAS bf16_t*)(lds + 2 * 34816);
                LAS bf16_t* sXt = (LAS bf16_t*)(lds + 3 * 34816);
                LAS bf16_t* sH = (LAS bf16_t*)(lds + 3 * 34816 + 17408);
                LAS float* sArr = (LAS float*)(lds + 3 * 34816 + 2 * 17408);
                LAS float* sIf = sArr, *sSb = sArr + 128, *sDtf = sArr + 256, *sDtb = sArr + 384, *sWf = sArr + 512, *sWb = sArr + 640, *sEf = sArr + 768, *sEb = sArr + 896, *sScal = sArr + 1024;
                const int fr = lane & 15, fq = lane >> 4, w = wave;
                const float* alog = args.in[I_ALOG]; const float* dsk = args.in[I_DSK];
                for (int uu = 0;; ++uu) {
                    int ui;
                    if (G == 256) { if (bx < 64) { if (uu > 1) break; ui = uu == 0 ? bx : 64 + bx; } else { if (uu > 4) break; ui = 128 + (bx - 64) + 192 * uu; } }
                    else { ui = bx + uu * G; if (ui >= 1088) break; }
                    int seq_t0, nc, h, bctx = -1, blat = -1, pass;
                    if (ui < 64) { blat = ui >> 5; h = (ui >> 1) & 15; pass = ui & 1; seq_t0 = T_CTX + blat * 1024; nc = 8; }
                    else { const int ci = ui - 64; bctx = ci >> 5; h = (ci >> 1) & 15; pass = ci & 1; seq_t0 = bctx * 256; nc = 2; }
                    const int grp = h >> 3;
                    const float a_f = -expf(alog[h]), a_b = -expf(alog[16 + h]);
                    {
                        f32x4 hst[4];
#pragma unroll
                        for (int pt = 0; pt < 4; ++pt) {
                            if (blat >= 0) hst[pt] = *(const f32x4*)(args.in[I_STATE] + ((((size_t)blat * 2 + pass) * 16 + h) * 64 + 16 * pt + fr) * 128 + 16 * w + 4 * fq);
                            else hst[pt] = (f32x4){0.f, 0.f, 0.f, 0.f};
                            u32x2 pk; pk.x = pk2(hst[pt][0], hst[pt][1]); pk.y = pk2(hst[pt][2], hst[pt][3]);
                            *(LAS u32x2*)(sH + (16 * pt + fr) * LS + 16 * w + 4 * fq) = pk;
                        }
                        u32x4 rC[4], rB[4], rX[2]; float rd0 = 0.f, rd1 = 0.f;
#define SSD_PREFETCH(cidx) do { const int t0p = seq_t0 + 128 * (cidx); \
                            _Pragma("unroll") for (int i = 0; i < 4; ++i) { const int idx = tid + 512 * i, l = idx >> 4, n8 = (idx & 15) * 8; rC[i] = *(const u32x4*)(XC + (size_t)(t0p + l) * 1536 + 1280 + grp * 128 + n8); } \
                            _Pragma("unroll") for (int i = 0; i < 4; ++i) { const int idx = tid + 512 * i, l = idx & 127, n8 = (idx >> 7) * 8; rB[i] = *(const u32x4*)(XC + (size_t)(t0p + l) * 1536 + 1024 + grp * 128 + n8); } \
                            _Pragma("unroll") for (int i = 0; i < 2; ++i) { const int idx = tid + 512 * i, l = idx & 127, p8 = (idx >> 7) * 8; rX[i] = *(const u32x4*)(XC + (size_t)(t0p + l) * 1536 + h * 64 + p8); } \
                            if (w < 2) { rd0 = DT[(size_t)(t0p + 2 * lane) * 32 + w * 16 + h]; rd1 = DT[(size_t)(t0p + 2 * lane + 1) * 32 + w * 16 + h]; } } while (0)
                        SSD_PREFETCH(pass == 0 ? 0 : nc - 1);
                        for (int cc = 0; cc < nc; ++cc) {
                            const int c = pass == 0 ? cc : nc - 1 - cc;
                            const int t0 = seq_t0 + 128 * c;
                            f32x4 Y[4];
#pragma unroll
                            for (int pt = 0; pt < 4; ++pt) Y[pt] = (f32x4){0.f, 0.f, 0.f, 0.f};
#pragma unroll
                            for (int i = 0; i < 4; ++i) { const int idx = tid + 512 * i, l = idx >> 4, n8 = (idx & 15) * 8; *(LAS u32x4*)(sC + l * LS + n8) = rC[i]; }
#pragma unroll
                            for (int i = 0; i < 4; ++i) { const int idx = tid + 512 * i, l = idx & 127, n8 = (idx >> 7) * 8;
                                const u32x4 vb = rB[i];
                                if (pass == 0) *(LAS u32x4*)(sB + l * LS + n8) = vb;
#pragma unroll
                                for (int e = 0; e < 4; ++e) { sBt[(n8 + 2 * e) * LS + l] = (bf16_t)(vb[e] & 0xffffu); sBt[(n8 + 2 * e + 1) * LS + l] = (bf16_t)(vb[e] >> 16); } }
#pragma unroll
                            for (int i = 0; i < 2; ++i) { const int idx = tid + 512 * i, l = idx & 127, p8 = (idx >> 7) * 8;
                                const u32x4 vx = rX[i];
#pragma unroll
                                for (int e = 0; e < 4; ++e) { sXt[(p8 + 2 * e) * LS + l] = (bf16_t)(vx[e] & 0xffffu); sXt[(p8 + 2 * e + 1) * LS + l] = (bf16_t)(vx[e] >> 16); } }
                            if (w < 2) {
                                const float av = w == 0 ? a_f : a_b;
                                const float d0 = rd0, d1 = rd1;
                                const float e0 = d0 * av, e1 = d1 * av;
                                float s = e0 + e1;
#pragma unroll
                                for (int o = 1; o < 64; o <<= 1) { const float tt = __shfl_up(s, o); if (lane >= o) s += tt; }
                                const float tot = __shfl(s, 63);
                                if (w == 0) { const float i1 = s, i0 = s - e1;
                                    sIf[2 * lane] = i0; sIf[2 * lane + 1] = i1; sDtf[2 * lane] = d0; sDtf[2 * lane + 1] = d1;
                                    sWf[2 * lane] = __expf(tot - i0) * d0; sWf[2 * lane + 1] = __expf(tot - i1) * d1; sEf[2 * lane] = __expf(i0); sEf[2 * lane + 1] = __expf(i1);
                                    if (lane == 0) sScal[0] = __expf(tot);
                                } else { const float s0 = tot - (s - e0 - e1), s1 = tot - (s - e1);
                                    sSb[2 * lane] = s0; sSb[2 * lane + 1] = s1; sDtb[2 * lane] = d0; sDtb[2 * lane + 1] = d1;
                                    sWb[2 * lane] = __expf(tot - s0) * d0; sWb[2 * lane + 1] = __expf(tot - s1) * d1; sEb[2 * lane] = __expf(s0); sEb[2 * lane + 1] = __expf(s1);
                                    if (lane == 0) sScal[1] = __expf(tot);
                                }
                            }
                            LDS_BARRIER();
                            if (cc + 1 < nc) SSD_PREFETCH(pass == 0 ? cc + 1 : nc - 2 - cc);
                            const int l = 16 * w + fr;
                            bf16x8 cfrag[4];
#pragma unroll
                            for (int ks = 0; ks < 4; ++ks) cfrag[ks] = *(const LAS bf16x8*)(sC + l * LS + 32 * ks + 8 * fq);
                            if (pass == 0) {
#pragma unroll
                                for (int pt = 0; pt < 4; ++pt) Y[pt] = (f32x4){0.f, 0.f, 0.f, 0.f};
                                const float If_l = sIf[l], Sb_l = sSb[l];
#pragma unroll
                                for (int u = 0; u < 4; ++u) {
                                    unsigned mw[4];
#pragma unroll
                                    for (int hh = 0; hh < 2; ++hh) {
                                        const int st = 2 * u + hh;
                                        f32x4 gacc = {0.f, 0.f, 0.f, 0.f};
#pragma unroll
                                        for (int ks = 0; ks < 4; ++ks) { const bf16x8 bfrag = *(const LAS bf16x8*)(sB + (16 * st + fr) * LS + 32 * ks + 8 * fq); gacc = MFMA16(bfrag, cfrag[ks], gacc); }
                                        const int s0 = 16 * st + 4 * fq;
                                        f32x4 fac = {0.f, 0.f, 0.f, 0.f};
                                        if (st <= w) { const f32x4 is = *(const LAS f32x4*)(sIf + s0), ds = *(const LAS f32x4*)(sDtf + s0);
#pragma unroll
                                            for (int e = 0; e < 4; ++e) fac[e] += (s0 + e <= l) ? __expf(fminf(If_l - is[e], 0.f)) * ds[e] : 0.f; }
                                        if (st >= w) { const f32x4 ss = *(const LAS f32x4*)(sSb + s0), ds = *(const LAS f32x4*)(sDtb + s0);
#pragma unroll
                                            for (int e = 0; e < 4; ++e) fac[e] += (s0 + e >= l) ? __expf(fminf(Sb_l - ss[e], 0.f)) * ds[e] : 0.f; }
                                        gacc = gacc * fac;
                                        mw[2 * hh] = pk2(gacc[0], gacc[1]); mw[2 * hh + 1] = pk2(gacc[2], gacc[3]);
                                    }
                                    u32x4 mf = {mw[0], mw[1], mw[2], mw[3]};
                                    const bf16x8 mfrag = __builtin_bit_cast(bf16x8, mf);
#pragma unroll
                                    for (int pt = 0; pt < 4; ++pt) {
                                        const u32x2 xa = *(const LAS u32x2*)(sXt + (16 * pt + fr) * LS + 32 * u + 4 * fq), xb = *(const LAS u32x2*)(sXt + (16 * pt + fr) * LS + 32 * u + 16 + 4 * fq);
                                        u32x4 xf = {xa.x, xa.y, xb.x, xb.y};
                                        Y[pt] = MFMA16(__builtin_bit_cast(bf16x8, xf), mfrag, Y[pt]);
                                    }
                                }
                            }
                            if (!(bctx >= 0 && cc == 0)) {
                                const float el = pass == 0 ? sEf[l] : sEb[l];
#pragma unroll
                                for (int pt = 0; pt < 4; ++pt) { f32x4 yi = {0.f, 0.f, 0.f, 0.f};
#pragma unroll
                                    for (int ks = 0; ks < 4; ++ks) { const bf16x8 hf = *(const LAS bf16x8*)(sH + (16 * pt + fr) * LS + 32 * ks + 8 * fq); yi = MFMA16(hf, cfrag[ks], yi); }
                                    Y[pt] += yi * el; }
                            }
                            {
                                bf16_t* yp = (pass == 0 ? YPART : YB) + ((((size_t)(t0 >> 7)) * 16 + h) * 512 + tid) * 16;
                                u32x4 y0, y1;
                                y0.x = pk2(Y[0][0], Y[0][1]); y0.y = pk2(Y[0][2], Y[0][3]); y0.z = pk2(Y[1][0], Y[1][1]); y0.w = pk2(Y[1][2], Y[1][3]);
                                y1.x = pk2(Y[2][0], Y[2][1]); y1.y = pk2(Y[2][2], Y[2][3]); y1.z = pk2(Y[3][0], Y[3][1]); y1.w = pk2(Y[3][2], Y[3][3]);
                                *(u32x4*)yp = y0; *(u32x4*)(yp + 8) = y1;
                            }
                            LDS_BARRIER();
                            {
                                const float dec = sScal[pass];
                                const LAS float* sW = pass == 0 ? sWf : sWb;
#pragma unroll
                                for (int pt = 0; pt < 4; ++pt) hst[pt] = hst[pt] * dec;
#pragma unroll
                                for (int ks = 0; ks < 4; ++ks) {
                                    const u32x4 br = *(const LAS u32x4*)(sBt + (16 * w + fr) * LS + 32 * ks + 8 * fq);
                                    const f32x4 w0 = *(const LAS f32x4*)(sW + 32 * ks + 8 * fq), w1 = *(const LAS f32x4*)(sW + 32 * ks + 8 * fq + 4);
                                    u32x4 bs; bs.x = pk2(bflo(br.x) * w0[0], bfhi(br.x) * w0[1]); bs.y = pk2(bflo(br.y) * w0[2], bfhi(br.y) * w0[3]);
                                    bs.z = pk2(bflo(br.z) * w1[0], bfhi(br.z) * w1[1]); bs.w = pk2(bflo(br.w) * w1[2], bfhi(br.w) * w1[3]);
                                    const bf16x8 bfrag = __builtin_bit_cast(bf16x8, bs);
#pragma unroll
                                    for (int pt = 0; pt < 4; ++pt) {
                                        const bf16x8 xf = *(const LAS bf16x8*)(sXt + (16 * pt + fr) * LS + 32 * ks + 8 * fq);
                                        hst[pt] = MFMA16(bfrag, xf, hst[pt]);
                                    }
                                }
#pragma unroll
                                for (int pt = 0; pt < 4; ++pt) { u32x2 pk; pk.x = pk2(hst[pt][0], hst[pt][1]); pk.y = pk2(hst[pt][2], hst[pt][3]);
                                    *(LAS u32x2*)(sH + (16 * pt + fr) * LS + 16 * w + 4 * fq) = pk; }
                            }
                            LDS_BARRIER();
                        }
                        if (bctx >= 0) {
                            float* so = args.out + OUT_STATE + ((((size_t)bctx * 2 + pass) * 16 + h) * 64) * 128;
#pragma unroll
                            for (int pt = 0; pt < 4; ++pt) *(f32x4*)(so + (size_t)(16 * pt + fr) * 128 + 16 * w + 4 * fq) = hst[pt];
                        }
                    }
                }
            }
            SEAM(4);
            REP(5) if (IN(5)) {
                PHASE_IDS();
                const float* g = args.in[I_SNG]; const float* dsk = args.in[I_DSK];
                const int hh = lane >> 2, fq = lane & 3;
                const float Dsum = dsk[hh] + dsk[16 + hh];
                for (int m = gw; m < T; m += NGW) {
                    const int gc = m >> 7, l = m & 127, w = l >> 4, fr = l & 15;
                    const size_t base = ((((size_t)gc * 16 + hh) * 512) + w * 64 + fq * 16 + fr) * 16;
                    f32x4 y[4]; float ss = 0.f;
#pragma unroll
                    for (int pt = 0; pt < 4; ++pt) {
                        const int c0 = hh * 64 + 16 * pt + 4 * fq;
                        const u32x2 yfp = *(const u32x2*)(YPART + base + 4 * pt), ybp = *(const u32x2*)(YB + base + 4 * pt);
                        const float yf[4] = {bflo(yfp.x), bfhi(yfp.x), bflo(yfp.y), bfhi(yfp.y)}, yb[4] = {bflo(ybp.x), bfhi(ybp.x), bflo(ybp.y), bfhi(ybp.y)};
                        const u32x2 xv = *(const u32x2*)(XC + (size_t)m * 1536 + c0), zv = *(const u32x2*)(Zb + (size_t)m * 1024 + c0);
                        const float xs[4] = {bflo(xv.x), bfhi(xv.x), bflo(xv.y), bfhi(xv.y)}, zs[4] = {bflo(zv.x), bfhi(zv.x), bflo(zv.y), bfhi(zv.y)};
#pragma unroll
                        for (int e = 0; e < 4; ++e) { const float o = (yf[e] + yb[e] + xs[e] * Dsum) * silu_f(zs[e]); y[pt][e] = o; ss += o * o; }
                    }
                    const float rstd = 1.f / sqrtf(wave_sum(ss) * (1.f / 1024.f) + 1e-6f);
#pragma unroll
                    for (int pt = 0; pt < 4; ++pt) { const int c0 = hh * 64 + 16 * pt + 4 * fq; const f32x4 gg = *(const f32x4*)(g + c0);
                        u32x2 o; o.x = pk2(y[pt][0] * rstd * gg[0], y[pt][1] * rstd * gg[1]); o.y = pk2(y[pt][2] * rstd * gg[2], y[pt][3] * rstd * gg[3]);
                        *(u32x2*)(YCAT + (size_t)m * 2048 + c0) = o; }
                }
            }
            SEAM(5);
            if (IN(6)) { if (G > 160 && bx >= 160) prep_stage<1>(args, lds, bx - 160, G - 160); else { PHASE_WS(); pg8::Gemm g{YCAT, WMO, T, 1024, 2048}; pg8::StaticOrder S; S.init(T, 1024, G, bx); pg8::EpiResB<true> E{x_lo, x_hi, nullptr, XB, modl + 2048}; pg8::gemm_phase(lds, g, S, E); } if (G <= 160) prep_stage<1>(args, lds, bx, G); }
            if constexpr (false) {}
            if ((((unsigned)PROBE_MASK >> (6)) & 1u)) if (IN(6)) { PHASE_WS(); pg8::Gemm g{YCAT, WMO, T, 1024, 2048}; pg8::StaticOrder S; S.init(T, 1024, G, bx); pg8::EpiRes E{x_lo, x_hi, OUTY, modl + 2048}; pg8::gemm_phase(lds, g, S, E); }
            SEAM(6);
        } else {
            if (IN(12)) { PHASE_WS(); pg8::Gemm g{Hb, WQKV, T, NQKV, 1024}; pg8::StaticOrder S; S.init(T, NQKV, G, bx); pg8::EpiQKV E{QKV, args.out + OUT_K, args.out + OUT_V}; pg8::gemm_phase(lds, g, S, E); }
            if constexpr (false) {}
            if ((((unsigned)PROBE_MASK >> (12)) & 1u)) if (IN(12)) { PHASE_WS(); pg8::Gemm g{Hb, WQKV, T, NQKV, 1024}; pg8::StaticOrder S; S.init(T, NQKV, G, bx); pg8::EpiQKV E{QKV, args.out + OUT_K, args.out + OUT_V}; pg8::gemm_phase(lds, g, S, E); }
            SEAM(12);
            REP(13)
            if (IN(13) && !SKIP_ATT) {
                PHASE_IDS();
                const int fr = lane & 15, fq = lane >> 4, w = wave;
                const float SCL = 0.125f * 1.4426950408889634f;
                for (int unit = bx; unit < 256 && !SKIP_NA; unit += G) {
                    const int b = unit >> 7, h = (unit >> 3) & 15, rp = unit & 7;
                    const int r = 2 * rp + (w >> 2), j = w & 3;
                    const int rb = min(max(2 * rp - 4, 0), 8), rs = min(max(r - 4, 0), 8), ro = rs - rb;
                    const int cs = min(max(16 * j - 8, 0), 32);
                    constexpr int KS = 72;
                    LAS bf16_t* sKc = (LAS bf16_t*)lds;
                    LAS bf16_t* sKl = (LAS bf16_t*)(lds + 36864);
                    LAS float* sRpb = (LAS float*)(lds + 36864 + 82944);
                    const size_t tokb = (size_t)T_CTX + (size_t)b * 1024;
                    for (int idx = tid; idx < 256 * 8; idx += NTHREADS) { const int key = idx >> 3, d8 = (idx & 7) * 8;
                        const float* src = args.in[I_CK] + (((size_t)b * 256 + key) * 16 + h) * 64 + d8;
                        const f32x4 a = *(const f32x4*)src, c = *(const f32x4*)(src + 4);
                        u32x4 o; o.x = pk2(a[0], a[1]); o.y = pk2(a[2], a[3]); o.z = pk2(c[0], c[1]); o.w = pk2(c[2], c[3]);
                        *(LAS u32x4*)(sKc + key * KS + d8) = o; }
                    for (int idx = tid; idx < 576 * 8; idx += NTHREADS) { const int key = idx >> 3, d8 = (idx & 7) * 8; const int gr = rb + (key >> 6);
                        if (gr < 16) *(LAS u32x4*)(sKl + key * KS + d8) = *(const u32x4*)(QKV + (tokb + gr * 64 + (key & 63)) * NQKV + 1024 + h * 64 + d8); }
                    for (int idx = tid; idx < 465; idx += NTHREADS) sRpb[idx] = args.in[I_RPB][h * 465 + idx];
                    __syncthreads();
                    const size_t qtok = tokb + r * 64 + 16 * j + fr;
                    bf16x8 qf[2];
#pragma unroll
                    for (int ks = 0; ks < 2; ++ks) qf[ks] = *(const bf16x8*)(QKV + qtok * NQKV + h * 64 + 32 * ks + 8 * fq);
                    unsigned P1[8][4], P2[8][4]; float m1, l1, m2, l2;
                    {
                        f32x4 sc[16];
#pragma unroll
                        for (int t = 0; t < 16; ++t) { f32x4 a = {0.f, 0.f, 0.f, 0.f};
#pragma unroll
                            for (int ks = 0; ks < 2; ++ks) { const bf16x8 kf = *(const LAS bf16x8*)(sKc + (16 * t + fr) * KS + 32 * ks + 8 * fq); a = MFMA16(kf, qf[ks], a); }
                            sc[t] = a * SCL; }
                        float mx = -1e30f;
#pragma unroll
                        for (int t = 0; t < 16; ++t)
#pragma unroll
                            for (int e = 0; e < 4; ++e) mx = fmaxf(mx, sc[t][e]);
                        mx = fmaxf(mx, __shfl_xor(mx, 16)); mx = fmaxf(mx, __shfl_xor(mx, 32));
                        float sum = 0.f;
#pragma unroll
                        for (int t = 0; t < 16; ++t)
#pragma unroll
                            for (int e = 0; e < 4; ++e) { const float p = __builtin_amdgcn_exp2f(sc[t][e] - mx); sc[t][e] = p; sum += p; }
                        sum += __shfl_xor(sum, 16); sum += __shfl_xor(sum, 32);
                        m1 = mx; l1 = sum;
#pragma unroll
                        for (int u = 0; u < 8; ++u) { P1[u][0] = pk2(sc[2 * u][0], sc[2 * u][1]); P1[u][1] = pk2(sc[2 * u][2], sc[2 * u][3]); P1[u][2] = pk2(sc[2 * u + 1][0], sc[2 * u + 1][1]); P1[u][3] = pk2(sc[2 * u + 1][2], sc[2 * u + 1][3]); }
                    }
                    {
                        const int qcol = 16 * j + fr, cstart = min(max(qcol - 8, 0), 48);
                        f32x4 sc[16];
#pragma unroll
                        for (int t = 0; t < 16; ++t) { f32x4 a = {0.f, 0.f, 0.f, 0.f};
                            const int kr = t >> 1, kc0 = 16 * (t & 1);
#pragma unroll
                            for (int ks = 0; ks < 2; ++ks) { const bf16x8 kf = *(const LAS bf16x8*)(sKl + ((ro + kr) * 64 + cs + kc0 + fr) * KS + 32 * ks + 8 * fq); a = MFMA16(kf, qf[ks], a); }
                            const int dr = rs + kr - r + 7;
#pragma unroll
                            for (int e = 0; e < 4; ++e) { const int col = cs + kc0 + 4 * fq + e; const int dc = min(max(col - qcol + 15, 0), 30);
                                const bool ok = col >= cstart && col < cstart + 16;
                                a[e] = ok ? (a[e] * 0.125f + sRpb[dr * 31 + dc]) * 1.4426950408889634f : -1e30f; }
                            sc[t] = a; }
                        float mx = -1e30f;
#pragma unroll
                        for (int t = 0; t < 16; ++t)
#pragma unroll
                            for (int e = 0; e < 4; ++e) mx = fmaxf(mx, sc[t][e]);
                        mx = fmaxf(mx, __shfl_xor(mx, 16)); mx = fmaxf(mx, __shfl_xor(mx, 32));
                        float sum = 0.f;
#pragma unroll
                        for (int t = 0; t < 16; ++t)
#pragma unroll
                            for (int e = 0; e < 4; ++e) { const float p = __builtin_amdgcn_exp2f(sc[t][e] - mx); sc[t][e] = p; sum += p; }
                        sum += __shfl_xor(sum, 16); sum += __shfl_xor(sum, 32);
                        m2 = mx; l2 = sum;
#pragma unroll
                        for (int u = 0; u < 8; ++u) { P2[u][0] = pk2(sc[2 * u][0], sc[2 * u][1]); P2[u][1] = pk2(sc[2 * u][2], sc[2 * u][3]); P2[u][2] = pk2(sc[2 * u + 1][0], sc[2 * u + 1][1]); P2[u][3] = pk2(sc[2 * u + 1][2], sc[2 * u + 1][3]); }
                    }
                    const float mm = fmaxf(m1, m2), f1 = __builtin_amdgcn_exp2f(m1 - mm), f2 = __builtin_amdgcn_exp2f(m2 - mm);
                    const float inv = 1.f / (l1 * f1 + l2 * f2), g1 = f1 * inv, g2 = f2 * inv;
                    __syncthreads();
                    constexpr int VCS = 264, VLS = 584;
                    LAS bf16_t* sVc = (LAS bf16_t*)lds;
                    LAS bf16_t* sVl = (LAS bf16_t*)(lds + 33792);
                    for (int idx = tid; idx < 256 * 8; idx += NTHREADS) { const int key = idx & 255, d8 = (idx >> 8) * 8;
                        const float* src = args.in[I_CV] + (((size_t)b * 256 + key) * 16 + h) * 64 + d8;
                        const f32x4 a = *(const f32x4*)src, c = *(const f32x4*)(src + 4);
#pragma unroll
                        for (int e = 0; e < 4; ++e) { sVc[(d8 + e) * VCS + key] = (bf16_t)f2bf(a[e]); sVc[(d8 + 4 + e) * VCS + key] = (bf16_t)f2bf(c[e]); } }
                    for (int idx = tid; idx < 576 * 8; idx += NTHREADS) { const int key = idx % 576, d8 = (idx / 576) * 8; const int gr = rb + (key >> 6);
                        if (gr < 16) { const u32x4 v = *(const u32x4*)(QKV + (tokb + gr * 64 + (key & 63)) * NQKV + 2048 + h * 64 + d8);
#pragma unroll
                            for (int e = 0; e < 4; ++e) { sVl[(d8 + 2 * e) * VLS + key] = (bf16_t)(v[e] & 0xffffu); sVl[(d8 + 2 * e + 1) * VLS + key] = (bf16_t)(v[e] >> 16); } } }
                    __syncthreads();
                    f32x4 O1[4], O2[4];
#pragma unroll
                    for (int dt = 0; dt < 4; ++dt) { O1[dt] = (f32x4){0.f, 0.f, 0.f, 0.f}; O2[dt] = (f32x4){0.f, 0.f, 0.f, 0.f}; }
#pragma unroll
                    for (int u = 0; u < 8; ++u) {
                        const u32x4 pf = {P1[u][0], P1[u][1], P1[u][2], P1[u][3]};
#pragma unroll
                        for (int dt = 0; dt < 4; ++dt) { const u32x2 va = *(const LAS u32x2*)(sVc + (16 * dt + fr) * VCS + 32 * u + 4 * fq), vb = *(const LAS u32x2*)(sVc + (16 * dt + fr) * VCS + 32 * u + 16 + 4 * fq);
                            u32x4 vf = {va.x, va.y, vb.x, vb.y}; O1[dt] = MFMA16(__builtin_bit_cast(bf16x8, vf), __builtin_bit_cast(bf16x8, pf), O1[dt]); }
                    }
#pragma unroll
                    for (int u = 0; u < 8; ++u) {
                        const u32x4 pf = {P2[u][0], P2[u][1], P2[u][2], P2[u][3]};
                        const int kb = (ro + u) * 64 + cs + 4 * fq;
#pragma unroll
                        for (int dt = 0; dt < 4; ++dt) { const u32x2 va = *(const LAS u32x2*)(sVl + (16 * dt + fr) * VLS + kb), vb = *(const LAS u32x2*)(sVl + (16 * dt + fr) * VLS + kb + 16);
                            u32x4 vf = {va.x, va.y, vb.x, vb.y}; O2[dt] = MFMA16(__builtin_bit_cast(bf16x8, vf), __builtin_bit_cast(bf16x8, pf), O2[dt]); }
                    }
#pragma unroll
                    for (int dt = 0; dt < 4; ++dt) { const f32x4 o = O1[dt] * g1 + O2[dt] * g2; u32x2 pk; pk.x = pk2(o[0], o[1]); pk.y = pk2(o[2], o[3]);
                        *(u32x2*)(ATT + qtok * 1024 + h * 64 + 16 * dt + 4 * fq) = pk; }
                    __syncthreads();
                }
                for (int unit = bx; unit < 512; unit += G) {
                    const int b = unit >> 4, h = unit & 15;
                    constexpr int KS = 72, VS = 264;
                    LAS bf16_t* sK = (LAS bf16_t*)lds;
                    LAS bf16_t* sVt = (LAS bf16_t*)(lds + 36864);
                    const size_t tokb = (size_t)b * 256;
                    for (int idx = tid; idx < 256 * 8; idx += NTHREADS) { const int key = idx >> 3, d8 = (idx & 7) * 8;
                        *(LAS u32x4*)(sK + key * KS + d8) = *(const u32x4*)(QKV + (tokb + key) * NQKV + 1024 + h * 64 + d8); }
                    for (int idx = tid; idx < 256 * 8; idx += NTHREADS) { const int key = idx & 255, d8 = (idx >> 8) * 8;
                        const u32x4 v = *(const u32x4*)(QKV + (tokb + key) * NQKV + 2048 + h * 64 + d8);
#pragma unroll
                        for (int e = 0; e < 4; ++e) { sVt[(d8 + 2 * e) * VS + key] = (bf16_t)(v[e] & 0xffffu); sVt[(d8 + 2 * e + 1) * VS + key] = (bf16_t)(v[e] >> 16); } }
                    __syncthreads();
                    for (int qt = 0; qt < 2; ++qt) {
                        const size_t qtok = tokb + 32 * w + 16 * qt + fr;
                        bf16x8 qf[2];
#pragma unroll
                        for (int ks = 0; ks < 2; ++ks) qf[ks] = *(const bf16x8*)(QKV + qtok * NQKV + h * 64 + 32 * ks + 8 * fq);
                        f32x4 sc[16];
#pragma unroll
                        for (int t = 0; t < 16; ++t) { f32x4 a = {0.f, 0.f, 0.f, 0.f};
#pragma unroll
                            for (int ks = 0; ks < 2; ++ks) { const bf16x8 kf = *(const LAS bf16x8*)(sK + (16 * t + fr) * KS + 32 * ks + 8 * fq); a = MFMA16(kf, qf[ks], a); }
                            sc[t] = a * SCL; }
                        float mx = -1e30f;
#pragma unroll
                        for (int t = 0; t < 16; ++t)
#pragma unroll
                            for (int e = 0; e < 4; ++e) mx = fmaxf(mx, sc[t][e]);
                        mx = fmaxf(mx, __shfl_xor(mx, 16)); mx = fmaxf(mx, __shfl_xor(mx, 32));
                        float sum = 0.f;
#pragma unroll
                        for (int t = 0; t < 16; ++t)
#pragma unroll
                            for (int e = 0; e < 4; ++e) { const float p = __builtin_amdgcn_exp2f(sc[t][e] - mx); sc[t][e] = p; sum += p; }
                        sum += __shfl_xor(sum, 16); sum += __shfl_xor(sum, 32);
                        const float inv = 1.f / sum;
                        f32x4 O[4];
#pragma unroll
                        for (int dt = 0; dt < 4; ++dt) O[dt] = (f32x4){0.f, 0.f, 0.f, 0.f};
#pragma unroll
                        for (int u = 0; u < 8; ++u) {
                            u32x4 pf; pf.x = pk2(sc[2 * u][0], sc[2 * u][1]); pf.y = pk2(sc[2 * u][2], sc[2 * u][3]); pf.z = pk2(sc[2 * u + 1][0], sc[2 * u + 1][1]); pf.w = pk2(sc[2 * u + 1][2], sc[2 * u + 1][3]);
#pragma unroll
                            for (int dt = 0; dt < 4; ++dt) { const u32x2 va = *(const LAS u32x2*)(sVt + (16 * dt + fr) * VS + 32 * u + 4 * fq), vb = *(const LAS u32x2*)(sVt + (16 * dt + fr) * VS + 32 * u + 16 + 4 * fq);
                                u32x4 vf = {va.x, va.y, vb.x, vb.y}; O[dt] = MFMA16(__builtin_bit_cast(bf16x8, vf), __builtin_bit_cast(bf16x8, pf), O[dt]); }
                        }
#pragma unroll
                        for (int dt = 0; dt < 4; ++dt) { u32x2 pk; pk.x = pk2(O[dt][0] * inv, O[dt][1] * inv); pk.y = pk2(O[dt][2] * inv, O[dt][3] * inv);
                            *(u32x2*)(ATT + qtok * 1024 + h * 64 + 16 * dt + 4 * fq) = pk; }
                    }
                    __syncthreads();
                }
            }
            SEAM(13);
            if (IN(14)) { PHASE_WS(); pg8::Gemm g{ATT, WNAO, T, 1024, 1024}; pg8::StaticOrder S; S.init(T, 1024, G, bx); pg8::EpiResB<false> E{nullptr, nullptr, XB, XB, modl + 2048}; pg8::gemm_phase(lds, g, S, E); }
            SEAM(14);
        }
        const int pf = layer == 0 ? 7 : 15;
        REP(pf) if (IN(pf)) {
            PHASE_IDS();
            const float* g = args.in[I_NFG] + layer * 1024;
            { const int rpw = (T + NGW - 1) / NGW, r0 = gw * rpw, r1 = min(T, r0 + rpw);
              norm_rows(r0, r1, nullptr, nullptr, XB, g, modl, 3072, Hb, nullptr, lane); }
            const bf16_t* WG = (const bf16_t*)(ws + (layer ? WS_WGU1 : WS_WGU0));
            float* HALO = (float*)(ws + WS_HALO);
            for (int it = gw; it < 12 * 176; it += NGW) {
                const int hr = it / 176, cb = it % 176;
                const int sq = hr / 6, kk = (hr % 6) >> 1, side = hr & 1;
                const int m = T_CTX + sq * 1024 + 256 * (kk + 1) - 1 + side;
                const float* sh = modl + (1 + sq) * 6144 + 3072; const float* sc = modl + (1 + sq) * 6144 + 4096;
                const u32x2* xr = (const u32x2*)(XB + (size_t)m * 1024) + lane;
                f32x4 v[4]; float ss = 0.f;
#pragma unroll
                for (int j = 0; j < 4; ++j) { v[j] = bf4_to_f32(xr[64 * j]); ss += (v[j].x * v[j].x + v[j].y * v[j].y) + (v[j].z * v[j].z + v[j].w * v[j].w); }
                const float rstd = 1.f / sqrtf(wave_sum(ss) * (1.f / 1024.f) + 1e-6f);
#pragma unroll
                for (int j = 0; j < 4; ++j) { const f32x4 gg = ((const f32x4*)g)[lane + 64 * j], a = ((const f32x4*)sc)[lane + 64 * j], b = ((const f32x4*)sh)[lane + 64 * j];
                    const f32x4 y = v[j] * rstd * gg * (a + 1.f) + b; const unsigned p0 = pk2(y.x, y.y), p1 = pk2(y.z, y.w);
                    v[j] = (f32x4){bflo(p0), bfhi(p0), bflo(p1), bfhi(p1)}; }
#pragma unroll
                for (int cbat = 0; cbat < 2; ++cbat) {
                    u32x2 wv[8][4];
#pragma unroll
                    for (int c = 0; c < 8; ++c) { const int gc = cb * 16 + cbat * 8 + c; const bf16_t* wrow = WG + (size_t)(256 * (gc >> 7) + (gc & 127)) * 1024;
#pragma unroll
                        for (int j = 0; j < 4; ++j) wv[c][j] = ((const u32x2*)wrow)[lane + 64 * j]; }
                    float dd[8];
#pragma unroll
                    for (int c = 0; c < 8; ++c) { float d = 0.f;
#pragma unroll
                        for (int j = 0; j < 4; ++j) d += v[j].x * bflo(wv[c][j].x) + v[j].y * bfhi(wv[c][j].x) + v[j].z * bflo(wv[c][j].y) + v[j].w * bfhi(wv[c][j].y);
                        dd[c] = wave_sum(d); }
                    if (lane == 0) { float* hp_ = HALO + (size_t)hr * DFF + cb * 16 + cbat * 8;
                        *(f32x4*)hp_ = (f32x4){dd[0], dd[1], dd[2], dd[3]}; *(f32x4*)(hp_ + 4) = (f32x4){dd[4], dd[5], dd[6], dd[7]}; }
                }
            }
        }
        SEAM(pf);
        if (IN(pf + 1)) { PHASE_WS(); pg8::Gemm g{Hb, (const bf16_t*)(ws + (layer ? WS_WGU1 : WS_WGU0)), T, NGU, 1024}; pg8::StaticOrder S; S.init(T, NGU, G, bx); pg8::EpiGUF E{ACT, args.in[I_FCW] + (size_t)layer * 3 * DFF, (const float*)(ws + WS_HALO), (LAS float*)(lds + 131072)}; pg8::gemm_phase(lds, g, S, E); }
        if constexpr (false) {}
        if ((((unsigned)PROBE_MASK >> ((pf + 1))) & 1u)) if (IN(pf + 1)) { PHASE_WS(); pg8::Gemm g{Hb, (const bf16_t*)(ws + (layer ? WS_WGU1 : WS_WGU0)), T, NGU, 1024}; pg8::StaticOrder S; S.init(T, NGU, G, bx); pg8::EpiGUF E{ACT, args.in[I_FCW] + (size_t)layer * 3 * DFF, (const float*)(ws + WS_HALO), (LAS float*)(lds + 131072)}; pg8::gemm_phase(lds, g, S, E); }
        SEAM(pf + 1);
        if (IN(pf + 3)) { if (layer == 0 && G > 160 && bx >= 160) prep_stage<2>(args, lds, bx - 160, G - 160); else { PHASE_WS(); pg8::Gemm g{ACT, (const bf16_t*)(ws + (layer ? WS_WDN1 : WS_WDN0)), T, 1024, DFF}; pg8::StaticOrder S; S.init(T, 1024, G, bx); pg8::EpiResB<false> E{nullptr, nullptr, XB, XB, modl + 5120}; pg8::gemm_phase(lds, g, S, E); } if (layer == 0 && G <= 160) prep_stage<2>(args, lds, bx, G); }
        SEAM(pf + 3);

}

__global__ void __launch_bounds__(NTHREADS, 2) fwd_mega(Args args) {
    extern __shared__ __attribute__((aligned(16))) unsigned char lds_raw[];
    LAS unsigned char* lds = (LAS unsigned char*)lds_raw;
    cg::grid_group grid = cg::this_grid();
    const int G = gridDim.x, bx = blockIdx.x;
    const int lo = args.ph_lo, hi = args.ph_hi;
    if (threadIdx.x < 16) ((volatile LAS unsigned*)(lds + MISC_OFF))[threadIdx.x] = 0u;
    __syncthreads();
    if (hi - lo > 1 && threadIdx.x == 0) (void)xb_add(&((unsigned*)(args.ws + WS_BAR))[XB_XCNT(xb_xcc_id())], 1u);
    if (hi > 1000) grid.sync();
    if (IN(0)) prep_stage<0>(args, lds, blockIdx.x, gridDim.x);
    SEAM(0);

    layer_body<0>(args, lds, grid, lo, hi);
    layer_body<1>(args, lds, grid, lo, hi);
    if (IN(19)) {
        PHASE_IDS();
        const float* g = args.in[I_FNG];
        { const int rpw = (T + NGW - 1) / NGW, r0 = gw * rpw, r1 = min(T, r0 + rpw); norm_rows(r0, r1, nullptr, nullptr, XB, g, nullptr, 0, nullptr, OUTY, lane); }
    }
#undef IN
#undef SEAM
}

#ifndef N_LAUNCH_PER_PHASE
#define N_LAUNCH_PER_PHASE 0
#endif
extern "C" void kernel_launch(void* const* d_in, const int* in_sizes, int n_in, void* d_out, int out_size, void* d_ws, size_t ws_size, hipStream_t stream) {
    static int grid = 0;
    if (grid == 0) {
        if (n_in != 28 || ws_size < WS_END) { fprintf(stderr, "kernel_launch: unexpected n_in %d or ws %zu (< %zu)\n", n_in, ws_size, (size_t)WS_END); grid = -1; return; }
        int dev = 0, cus = 0, per_cu = 0;
        hipGetDevice(&dev); hipDeviceGetAttribute(&cus, hipDeviceAttributeMultiprocessorCount, dev);
        if (hipFuncSetAttribute((const void*)fwd_mega, hipFuncAttributeMaxDynamicSharedMemorySize, LDS_BYTES) != hipSuccess) { fprintf(stderr, "hipFuncSetAttribute failed\n"); grid = -1; return; }
        if (hipOccupancyMaxActiveBlocksPerMultiprocessor(&per_cu, (const void*)fwd_mega, NTHREADS, LDS_BYTES) != hipSuccess || per_cu < 1) { fprintf(stderr, "occupancy query: %d\n", per_cu); per_cu = 1; }
        (void)hipGetLastError();
        grid = cus;
    }
    if (grid < 0) return;
    if (hipMemsetAsync((char*)d_ws + WS_BAR, 0, 16384, stream) != hipSuccess) { fprintf(stderr, "memset failed\n"); return; }
    Args a{};
    for (int i = 0; i < 28; ++i) a.in[i] = (const float*)d_in[i];
    a.out = (float*)d_out; a.ws = (unsigned char*)d_ws;
#if N_LAUNCH_PER_PHASE
    for (int ph = 0; ph < 20; ++ph) { a.ph_lo = ph; a.ph_hi = ph + 1; hipLaunchKernelGGL(fwd_mega, dim3(grid), dim3(NTHREADS), LDS_BYTES, stream, a); }
#else
    a.ph_lo = 0; a.ph_hi = 20;
    void* kargs[] = {&a};
    hipError_t e = hipLaunchCooperativeKernel((const void*)fwd_mega, dim3(grid), dim3(NTHREADS), kargs, LDS_BYTES, stream);
    if (e != hipSuccess) fprintf(stderr, "cooperative launch failed: %s (grid %d)\n", hipGetErrorString(e), grid);
#endif
}
```

```cpp
#include <hip/hip_runtime.h>
#include <hip/hip_cooperative_groups.h>
#include <cstdio>
#include <cstdint>
namespace cg = cooperative_groups;

#define LAS __attribute__((address_space(3)))
typedef unsigned short bf16_t;
typedef short bf16x8 __attribute__((ext_vector_type(8)));
typedef float f32x4 __attribute__((ext_vector_type(4)));
typedef float f32x2 __attribute__((ext_vector_type(2)));
typedef unsigned u32x4 __attribute__((ext_vector_type(4)));
typedef unsigned u32x2 __attribute__((ext_vector_type(2)));

constexpr int D = 1024, T_CTX = 8192, T_LAT = 2048, T = 10240;
constexpr int NIN_SRC = 5664, NIN = 5888, NGU = 5632, DFF = 2816, NQKV = 3072;
constexpr int NTHREADS = 512, NWAVES = 8;
constexpr int LDS_BYTES = 147456;

constexpr size_t WS_BAR = 0;
constexpr size_t WS_MOD = 16384;
constexpr size_t WS_WIN = 262144;
constexpr size_t WS_WMO = WS_WIN + (size_t)NIN * 1024 * 2;
constexpr size_t WS_WGU0 = WS_WMO + (size_t)1024 * 2048 * 2;
constexpr size_t WS_WGU1 = WS_WGU0 + (size_t)NGU * 1024 * 2;
constexpr size_t WS_WDN0 = WS_WGU1 + (size_t)NGU * 1024 * 2;
constexpr size_t WS_WDN1 = WS_WDN0 + (size_t)1024 * DFF * 2;
constexpr size_t WS_WQKV = WS_WDN1 + (size_t)1024 * DFF * 2;
constexpr size_t WS_WNAO = WS_WQKV + (size_t)NQKV * 1024 * 2;
constexpr size_t WS_R1 = 62914560;
static_assert(WS_WNAO + (size_t)1024 * 1024 * 2 <= WS_R1, "weights overflow");
constexpr size_t WS_Z = WS_R1;
constexpr size_t WS_XR = WS_Z + (size_t)T * 1024 * 2;
constexpr size_t WS_BCX = WS_XR + (size_t)T * 1536 * 2;
constexpr size_t WS_GU = WS_R1;
constexpr size_t WS_QKV = WS_R1;
constexpr size_t WS_YB = WS_XR;
constexpr size_t WS_YPART = WS_XR + (size_t)T * 1024 * 4;
static_assert(WS_YPART + (size_t)T * 1024 * 4 <= WS_BCX + (size_t)T * 3072 * 2, "SSD partials overflow R1");
constexpr size_t WS_XB = WS_R1 + 67108864;
constexpr size_t WS_R2 = WS_R1 + (size_t)T * 5632 * 2;
static_assert(WS_XB + (size_t)T * 1024 * 2 <= WS_R2 && (size_t)T * 3072 * 2 <= 67108864, "residual stream placement");
constexpr size_t WS_XC = WS_R2;
constexpr size_t WS_YCAT = WS_XC + (size_t)T * 1536 * 2;
constexpr size_t WS_H = WS_R2;
constexpr size_t WS_ACT = WS_R1;
constexpr size_t WS_ATT = WS_R2;
constexpr size_t WS_DTRAW = WS_YCAT + (size_t)T * 2048 * 2;
constexpr size_t WS_DT = WS_DTRAW + (size_t)T * 32 * 4;
constexpr size_t WS_HALO = WS_DT + (size_t)T * 32 * 4;
constexpr size_t WS_END = WS_HALO + (size_t)12 * 2816 * 4;
static_assert(WS_END <= 268435456ull, "workspace over 256 MiB");

constexpr size_t OUT_Y = 0, OUT_STATE = 10485760, OUT_K = 18874368, OUT_V = 27262976;

__device__ __forceinline__ unsigned f2bf(float f) { unsigned u = __builtin_bit_cast(unsigned, f); return (u + 0x7fffu + ((u >> 16) & 1u)) >> 16; }
__device__ __forceinline__ unsigned pk2(float lo, float hi) { unsigned r; asm("v_cvt_pk_bf16_f32 %0, %1, %2" : "=v"(r) : "v"(lo), "v"(hi)); return r; }
__device__ __forceinline__ float bflo(unsigned w) { return __builtin_bit_cast(float, w << 16); }
__device__ __forceinline__ float bfhi(unsigned w) { return __builtin_bit_cast(float, w & 0xffff0000u); }
__device__ __forceinline__ float bf1(bf16_t h) { return __builtin_bit_cast(float, ((unsigned)h) << 16); }
__device__ __forceinline__ float wave_sum(float v) {
#pragma unroll
    for (int o = 1; o < 64; o <<= 1) v += __shfl_xor(v, o);
    return v;
}
__device__ __forceinline__ float silu_f(float x) { return x * __builtin_amdgcn_rcpf(1.f + __builtin_amdgcn_exp2f(-1.4426950409f * x)); }
__device__ __forceinline__ float gelu_fast(float x) { const float t = x * (1.5957691216f + 0.0713548163f * x * x); return x * __builtin_amdgcn_rcpf(1.f + __builtin_amdgcn_exp2f(-1.4426950409f * t)); }
__device__ __forceinline__ float gelu_tanh_f(float x) {
    const float u = 0.7978845608028654f * (x + 0.044715f * x * x * x);
    const float e = __expf(-2.f * fabsf(u)); float th = (1.f - e) / (1.f + e); th = u < 0.f ? -th : th;
    return 0.5f * x * (1.f + th);
}
#define LDS_BARRIER() do { asm volatile("s_waitcnt lgkmcnt(0)" ::: "memory"); __builtin_amdgcn_s_barrier(); asm volatile("" ::: "memory"); } while (0)
#define MFMA16(a, b, c) __builtin_amdgcn_mfma_f32_16x16x32_bf16((a), (b), (c), 0, 0, 0)

namespace pg8 {
constexpr int BM = 256, BK = 64, HALF = 128, HTB = HALF * BK * 2, STAGE_BYTES = 8 * HTB, NXCD = 8, WGM = 8;
__host__ __device__ __forceinline__ int lds_byte(int r, int c) { const int st = (r >> 4) * 2 + (c >> 5), rr = r & 15, cc = c & 31, ob = rr * 64 + cc * 2; return st * 1024 + (ob ^ (((ob >> 9) & 1) << 5)); }
__host__ __device__ __forceinline__ void stage_rc(int b, int& R, int& C) { const int st = b / 1024, sb = b % 1024, swz = sb ^ (((sb >> 9) & 1) << 5); R = (st >> 1) * 16 + swz / 64; C = (st & 1) * 32 + (swz % 64) / 2; }
__host__ __device__ __forceinline__ int perm32(int rho) { const int n = rho >> 4, i = rho & 15; return 8 * (i >> 2) + 4 * n + (i & 3); }
struct Unit { int pm, pn; };
struct Gemm { const bf16_t* A; const bf16_t* Bt; int M, N, K; };
struct StaticOrder {
    int nM, nN, nwg, G, c;
    __device__ void init(int M, int N, int G_, int c_) { nM = M / BM; nN = N / BM; nwg = nM * nN; G = G_; c = c_; }
    __device__ bool next(int i, Unit& u) const {
        const long L = (long)i * G + c; if (L >= nwg) return false;
        int wgid = (int)L; { const int q = nwg / NXCD, r = nwg % NXCD, xcd = wgid % NXCD, off = wgid / NXCD; wgid = (xcd < r ? xcd * (q + 1) : r * (q + 1) + (xcd - r) * q) + off; }
        const int nig = WGM * nN, gid = wgid / nig, fm = gid * WGM, gsz = (nM - fm) < WGM ? (nM - fm) : WGM;
        u.pm = fm + ((wgid % nig) % gsz); u.pn = (wgid % nig) / gsz; return true;
    }
};
__device__ __forceinline__ unsigned cvt_pk_bf16(float lo, float hi) { unsigned r; asm volatile("v_cvt_pk_bf16_f32 %0, %1, %2" : "=v"(r) : "v"(lo), "v"(hi)); return r; }

__device__ __forceinline__ void store_bf16_tile(const f32x4 (&acc)[2][2][4][2], bf16_t* base, int ldc, int row0, int col0) {
#pragma unroll
    for (int ai = 0; ai < 2; ++ai)
#pragma unroll
        for (int m = 0; m < 4; ++m) { bf16_t* rowp = base + (size_t)(row0 + ai * HALF + m * 16) * ldc + col0;
#pragma unroll
            for (int bj = 0; bj < 2; ++bj) { const f32x4 v0 = acc[ai][bj][m][0], v1 = acc[ai][bj][m][1];
                u32x4 w; w.x = cvt_pk_bf16(v0[0], v0[1]); w.y = cvt_pk_bf16(v0[2], v0[3]); w.z = cvt_pk_bf16(v1[0], v1[1]); w.w = cvt_pk_bf16(v1[2], v1[3]);
                *(u32x4*)(rowp + bj * HALF) = w; } }
}
struct EpiIn {
    static constexpr bool PERM = true, ALIGN = false;
    bf16_t* Z; bf16_t* XR; bf16_t* BCX; float* DTRAW;
    __device__ __forceinline__ void operator()(const f32x4 (&acc)[2][2][4][2], const Unit& u, int wr, int wc, int fr, int fq) const {
        const int row0 = u.pm * BM + wr * 64 + fr;
        if (u.pn == 22) {
            if (wc == 0) {
#pragma unroll
                for (int ai = 0; ai < 2; ++ai)
#pragma unroll
                    for (int m = 0; m < 4; ++m) { float* p = DTRAW + (size_t)(row0 + ai * HALF + m * 16) * 32 + 8 * fq;
                        *(f32x4*)p = acc[ai][0][m][0]; *(f32x4*)(p + 4) = acc[ai][0][m][1]; }
            }
            return;
        }
        if (u.pn >= 14) {
            const int col0 = 1024 + (u.pn - 14) * 128 + wc * 32 + 8 * fq;
#pragma unroll
            for (int ai = 0; ai < 2; ++ai)
#pragma unroll
                for (int m = 0; m < 4; ++m) { const f32x4 p0 = acc[ai][0][m][0] * acc[ai][1][m][0], p1 = acc[ai][0][m][1] * acc[ai][1][m][1];
                    u32x4 w; w.x = cvt_pk_bf16(p0[0], p0[1]); w.y = cvt_pk_bf16(p0[2], p0[3]); w.z = cvt_pk_bf16(p1[0], p1[1]); w.w = cvt_pk_bf16(p1[2], p1[3]);
                    *(u32x4*)(BCX + (size_t)(row0 + ai * HALF + m * 16) * 3072 + col0) = w; }
            return;
        }
        bf16_t* base; int ldc, colt;
        if (u.pn < 4) { base = Z; ldc = 1024; colt = u.pn * 256; } else if (u.pn < 10) { base = XR; ldc = 1536; colt = (u.pn - 4) * 256; } else { base = BCX; ldc = 3072; colt = (u.pn - 10) * 256; }
        store_bf16_tile(acc, base, ldc, row0, colt + wc * 32 + 8 * fq);
    }
};
struct EpiBf {
    static constexpr bool PERM = true, ALIGN = false;
    bf16_t* O; int ldc;
    __device__ __forceinline__ void operator()(const f32x4 (&acc)[2][2][4][2], const Unit& u, int wr, int wc, int fr, int fq) const {
        store_bf16_tile(acc, O, ldc, u.pm * BM + wr * 64 + fr, u.pn * BM + wc * 32 + 8 * fq);
    }
};
struct EpiQKV {
    static constexpr bool PERM = true, ALIGN = false;
    bf16_t* O; float* OK; float* OV;
    __device__ __forceinline__ void operator()(const f32x4 (&acc)[2][2][4][2], const Unit& u, int wr, int wc, int fr, int fq) const {
        const int row0 = u.pm * BM + wr * 64 + fr, col0 = u.pn * BM + wc * 32 + 8 * fq;
        store_bf16_tile(acc, O, NQKV, row0, col0);
        if (u.pm < 32 && u.pn >= 4) {
            float* base = (u.pn < 8) ? (OK + (col0 - 1024)) : (OV + (col0 - 2048));
#pragma unroll
            for (int ai = 0; ai < 2; ++ai)
#pragma unroll
                for (int m = 0; m < 4; ++m) { float* rowp = base + (size_t)(row0 + ai * HALF + m * 16) * 1024;
#pragma unroll
                    for (int bj = 0; bj < 2; ++bj) { *(f32x4*)(rowp + bj * HALF) = acc[ai][bj][m][0]; *(f32x4*)(rowp + bj * HALF + 4) = acc[ai][bj][m][1]; } }
        }
    }
};
struct EpiRes {
    static constexpr bool PERM = false, ALIGN = false;
    const float* base_lo; const float* base_hi; float* out; const float* gate;
    __device__ __forceinline__ void operator()(const f32x4 (&acc)[2][2][4][2], const Unit& u, int wr, int wc, int fr, int fq) const {
        const int row0 = u.pm * BM + wr * 64 + fr, col0 = u.pn * BM + wc * 32 + 4 * fq;
        const int v = u.pm < 32 ? 0 : 1 + ((u.pm - 32) >> 2);
        const float* gv = gate + v * 6144 + col0;
        f32x4 g[2][2];
#pragma unroll
        for (int bj = 0; bj < 2; ++bj)
#pragma unroll
            for (int n = 0; n < 2; ++n) g[bj][n] = *(const f32x4*)(gv + bj * HALF + n * 16);
        const float* base = u.pm < 32 ? base_lo : base_hi;
        f32x4 bb[2][2][2][2];
#define EPIRES_LOAD(buf, gi) do { _Pragma("unroll") for (int mm = 0; mm < 2; ++mm) { const size_t off_ = (size_t)(row0 + ((gi) >> 1) * HALF + (2 * ((gi) & 1) + mm) * 16) * 1024 + col0; \
            _Pragma("unroll") for (int bj = 0; bj < 2; ++bj) _Pragma("unroll") for (int n = 0; n < 2; ++n) bb[buf][mm][bj][n] = *(const f32x4*)(base + off_ + bj * HALF + n * 16); } } while (0)
        EPIRES_LOAD(0, 0);
#pragma unroll
        for (int gi = 0; gi < 4; ++gi) {
            if (gi < 3) EPIRES_LOAD((gi + 1) & 1, gi + 1);
#pragma unroll
            for (int mm = 0; mm < 2; ++mm) { const int ai = gi >> 1, m = 2 * (gi & 1) + mm; const size_t off = (size_t)(row0 + ai * HALF + m * 16) * 1024 + col0;
#pragma unroll
                for (int bj = 0; bj < 2; ++bj)
#pragma unroll
                    for (int n = 0; n < 2; ++n) *(f32x4*)(out + off + bj * HALF + n * 16) = bb[gi & 1][mm][bj][n] + g[bj][n] * acc[ai][bj][m][n]; }
        }
#undef EPIRES_LOAD
    }
};

__device__ __forceinline__ f32x4 dpp_ror1(f32x4 v) { f32x4 r;
#pragma unroll
    for (int e = 0; e < 4; ++e) { const float x = v[e]; r[e] = __int_as_float(__builtin_amdgcn_update_dpp(0, __float_as_int(x), 0x121, 0xf, 0xf, false)); }
    return r; }
__device__ __forceinline__ f32x4 dpp_ror15(f32x4 v) { f32x4 r;
#pragma unroll
    for (int e = 0; e < 4; ++e) { const float x = v[e]; r[e] = __int_as_float(__builtin_amdgcn_update_dpp(0, __float_as_int(x), 0x12f, 0xf, 0xf, false)); }
    return r; }
struct EpiGUF {
    static constexpr bool PERM = true, ALIGN = true;
    bf16_t* ACTp; const float* fw; const float* HALO; LAS float* X;
    __device__ __forceinline__ void operator()(const f32x4 (&acc)[2][2][4][2], const Unit& u, int wr, int wc, int fr, int fq) const {
        const int cl = wc * 32 + 8 * fq;
        const int gc0 = u.pn * 128 + cl;
        f32x4 w0[2], w1[2], w2[2];
#pragma unroll
        for (int n = 0; n < 2; ++n) { w0[n] = *(const f32x4*)(fw + gc0 + 4 * n); w1[n] = *(const f32x4*)(fw + DFF + gc0 + 4 * n); w2[n] = *(const f32x4*)(fw + 2 * DFF + gc0 + 4 * n); }
        f32x4 hu[2], hd[2];
        {
            const f32x4 z = {0.f, 0.f, 0.f, 0.f};
            const bool lat = u.pm >= 32; const int q = (u.pm - 32) & 3, sq = (u.pm - 32) >> 2;
            const bool hasu = lat && q > 0, hasd = lat && q < 3;
            const float* pu = HALO + (size_t)(sq * 6 + 2 * (q - 1)) * DFF + gc0; const float* pd = HALO + (size_t)(sq * 6 + 2 * q + 1) * DFF + gc0;
#pragma unroll
            for (int n = 0; n < 2; ++n) { hu[n] = hasu ? *(const f32x4*)(pu + 4 * n) : z; hd[n] = hasd ? *(const f32x4*)(pd + 4 * n) : z; }
        }
#pragma unroll
        for (int ai = 0; ai < 2; ++ai) { const int rb = 2 * ai + wr;
            if (fr == 0) {
#pragma unroll
                for (int n = 0; n < 2; ++n) *(LAS f32x4*)(X + (rb * 2 + 0) * 128 + cl + 4 * n) = acc[ai][0][0][n]; }
            if (fr == 15) {
#pragma unroll
                for (int n = 0; n < 2; ++n) *(LAS f32x4*)(X + (rb * 2 + 1) * 128 + cl + 4 * n) = acc[ai][0][3][n]; } }
        asm volatile("s_waitcnt lgkmcnt(0)" ::: "memory"); __builtin_amdgcn_s_barrier(); asm volatile("" ::: "memory");
#pragma unroll
        for (int ai = 0; ai < 2; ++ai) { const int rb = 2 * ai + wr;
            f32x4 ux[2], dx[2];
#pragma unroll
            for (int n = 0; n < 2; ++n) {
                ux[n] = rb > 0 ? *(const LAS f32x4*)(X + ((rb - 1) * 2 + 1) * 128 + cl + 4 * n) : hu[n];
                dx[n] = rb < 3 ? *(const LAS f32x4*)(X + ((rb + 1) * 2 + 0) * 128 + cl + 4 * n) : hd[n]; }
#pragma unroll
            for (int m = 0; m < 4; ++m) {
                u32x4 o;
#pragma unroll
                for (int n = 0; n < 2; ++n) {
                    const f32x4 g = acc[ai][0][m][n];
                    const f32x4 tu = dpp_ror1(g), td = dpp_ror15(g);
                    f32x4 eu, ed;
                    if (m > 0) eu = dpp_ror1(acc[ai][0][m > 0 ? m - 1 : 0][n]); else eu = ux[n];
                    if (m < 3) ed = dpp_ror15(acc[ai][0][m < 3 ? m + 1 : 3][n]); else ed = dx[n];
                    f32x4 a;
#pragma unroll
                    for (int e = 0; e < 4; ++e) { const float up = fr > 0 ? tu[e] : eu[e], dn = fr < 15 ? td[e] : ed[e];
                        a[e] = gelu_fast(w0[n][e] * up + w1[n][e] * g[e] + w2[n][e] * dn) * acc[ai][1][m][n][e]; }
                    if (n == 0) { o.x = cvt_pk_bf16(a[0], a[1]); o.y = cvt_pk_bf16(a[2], a[3]); } else { o.z = cvt_pk_bf16(a[0], a[1]); o.w = cvt_pk_bf16(a[2], a[3]); }
                }
                *(u32x4*)(ACTp + (size_t)(u.pm * BM + ai * HALF + wr * 64 + m * 16 + fr) * DFF + gc0) = o;
            }
        }
    }
};

template <bool SRCF32> struct EpiResB {
    static constexpr bool PERM = true, ALIGN = false;
    const float* base_lo; const float* base_hi; const bf16_t* baseb; bf16_t* outb; const float* gate;
    __device__ __forceinline__ void operator()(const f32x4 (&acc)[2][2][4][2], const Unit& u, int wr, int wc, int fr, int fq) const {
        const int row0 = u.pm * BM + wr * 64 + fr, col0 = u.pn * BM + wc * 32 + 8 * fq;
        const int v = u.pm < 32 ? 0 : 1 + ((u.pm - 32) >> 2);
        const float* gv = gate + v * 6144 + col0;
        f32x4 g[2][2];
#pragma unroll
        for (int bj = 0; bj < 2; ++bj)
#pragma unroll
            for (int n = 0; n < 2; ++n) g[bj][n] = *(const f32x4*)(gv + bj * HALF + 4 * n);
        const float* basef = u.pm < 32 ? base_lo : base_hi;
        f32x4 bf_[2][2][2][2]; u32x4 bh_[2][2][2];
#define EPIRB_LOAD(buf, gi) do { _Pragma("unroll") for (int mm = 0; mm < 2; ++mm) { const size_t off_ = (size_t)(row0 + ((gi) >> 1) * HALF + (2 * ((gi) & 1) + mm) * 16) * 1024 + col0; \
            _Pragma("unroll") for (int bj = 0; bj < 2; ++bj) { if (SRCF32) { bf_[buf][mm][bj][0] = *(const f32x4*)(basef + off_ + bj * HALF); bf_[buf][mm][bj][1] = *(const f32x4*)(basef + off_ + bj * HALF + 4); } \
                else bh_[buf][mm][bj] = *(const u32x4*)(baseb + off_ + bj * HALF); } } } while (0)
        EPIRB_LOAD(0, 0);
#pragma unroll
        for (int gi = 0; gi < 4; ++gi) {
            if (gi < 3) EPIRB_LOAD((gi + 1) & 1, gi + 1);
#pragma unroll
            for (int mm = 0; mm < 2; ++mm) { const int ai = gi >> 1, m = 2 * (gi & 1) + mm; const size_t off = (size_t)(row0 + ai * HALF + m * 16) * 1024 + col0;
#pragma unroll
                for (int bj = 0; bj < 2; ++bj) {
                    f32x4 b0, b1;
                    if (SRCF32) { b0 = bf_[gi & 1][mm][bj][0]; b1 = bf_[gi & 1][mm][bj][1]; }
                    else { const u32x4 h = bh_[gi & 1][mm][bj]; b0 = (f32x4){bflo(h.x), bfhi(h.x), bflo(h.y), bfhi(h.y)}; b1 = (f32x4){bflo(h.z), bfhi(h.z), bflo(h.w), bfhi(h.w)}; }
                    const f32x4 x0 = b0 + g[bj][0] * acc[ai][bj][m][0], x1 = b1 + g[bj][1] * acc[ai][bj][m][1];
                    u32x4 w; w.x = cvt_pk_bf16(x0[0], x0[1]); w.y = cvt_pk_bf16(x0[2], x0[3]); w.z = cvt_pk_bf16(x1[0], x1[1]); w.w = cvt_pk_bf16(x1[2], x1[3]);
                    *(u32x4*)(outb + off + bj * HALF) = w; } }
        }
#undef EPIRB_LOAD
    }
};

template <class Epi>
__device__ __forceinline__ void gemm_phase(LAS unsigned char* lds, const Gemm g, const StaticOrder& S, const Epi& E) {
    int tid_ = threadIdx.x; asm volatile("" : "+v"(tid_));
    const int tid = tid_, wid = __builtin_amdgcn_readfirstlane(tid >> 6), lane = tid & 63, wr = wid >> 2, wc = wid & 3, fr = lane & 15, fq = lane >> 4;
    const int K = g.K, nt = K / BK;
    unsigned voffA[2], voffB[2];
#pragma unroll
    for (int i = 0; i < 2; ++i) { int R, C; stage_rc(tid * 16 + i * 8192, R, C); const int Rb = Epi::PERM ? ((R & ~31) + perm32(R & 31)) : R;
        voffA[i] = (unsigned)(R * K + C) * 2u; voffB[i] = (unsigned)(Rb * K + C) * 2u; }
    const size_t kstep = (size_t)(BK * 2);
    const size_t hstep = (size_t)HALF * K * 2;
    const size_t tstep = 2 * hstep;
    const unsigned ldsw = (unsigned)wid * 1024u;
    const int aoff = lds_byte(wr * 64 + fr, fq * 8), boff = lds_byte(wc * 32 + fr, fq * 8);
#define PG8_SA(b, h) (((b) * 2 + (h)) * HTB)
#define PG8_SB(b, h) ((4 + (b) * 2 + (h)) * HTB)
#define PG8_STAGE(bufoff, gbase, voff) do { _Pragma("unroll") for (int _i = 0; _i < 2; ++_i) \
        __builtin_amdgcn_global_load_lds((const unsigned*)((const char*)(gbase) + (voff)[_i]), (LAS unsigned*)(lds + (bufoff) + ldsw + _i * 8192), 16, 0, 0); } while (0)
#define PG8_LDA(dst, b, h) do { _Pragma("unroll") for (int m = 0; m < 4; ++m) _Pragma("unroll") for (int k = 0; k < 2; ++k) dst[m][k] = *(const LAS bf16x8*)(lds + PG8_SA(b, h) + aoff + m * 2048 + k * 1024); } while (0)
#define PG8_LDB(dst, b, h) do { _Pragma("unroll") for (int n = 0; n < 2; ++n) _Pragma("unroll") for (int k = 0; k < 2; ++k) dst[n][k] = *(const LAS bf16x8*)(lds + PG8_SB(b, h) + boff + n * 2048 + k * 1024); } while (0)
#define PG8_MMA(ai, bj, At, Bt) do { __builtin_amdgcn_s_setprio(1); _Pragma("unroll") for (int m = 0; m < 4; ++m) _Pragma("unroll") for (int n = 0; n < 2; ++n) _Pragma("unroll") for (int k = 0; k < 2; ++k) \
        acc[ai][bj][m][n] = __builtin_amdgcn_mfma_f32_16x16x32_bf16(Bt[n][k], At[m][k], acc[ai][bj][m][n], 0, 0, 0); __builtin_amdgcn_s_setprio(0); } while (0)
#define PG8_WAIT_V(n) asm volatile("s_waitcnt vmcnt(" #n ")" ::: "memory")
#define PG8_WAIT_L(n) asm volatile("s_waitcnt lgkmcnt(" #n ")" ::: "memory")
#define PG8_BAR __builtin_amdgcn_s_barrier()
#define PG8_SCHED __builtin_amdgcn_sched_barrier(0)
    Unit cur, nxt; int ui = 0;
    if (!S.next(0, cur)) return;
    if (S.nwg > S.G) {
        const int rounds = (S.nwg + S.G - 1) / S.G;
        if ((long)(rounds - 1) * S.G + S.c >= S.nwg) { for (int i = 0; i < 3; ++i) __builtin_amdgcn_s_sleep(127); }
    }
    f32x4 acc[2][2][4][2];
#pragma unroll
    for (int a = 0; a < 2; ++a)
#pragma unroll
        for (int b = 0; b < 2; ++b)
#pragma unroll
            for (int m = 0; m < 4; ++m)
#pragma unroll
                for (int n = 0; n < 2; ++n) acc[a][b][m][n] = (f32x4){0.f, 0.f, 0.f, 0.f};
    bf16x8 At[4][2], B0[2][2], B1[2][2];
    const char* cA = (const char*)g.A + (size_t)cur.pm * tstep; const char* cB = (const char*)g.Bt + (size_t)cur.pn * tstep;
    PG8_STAGE(PG8_SB(0, 0), cB, voffB); PG8_STAGE(PG8_SA(0, 0), cA, voffA); PG8_STAGE(PG8_SB(0, 1), cB + hstep, voffB); PG8_STAGE(PG8_SA(0, 1), cA + hstep, voffA);
    if (wr == 1) PG8_BAR;
    PG8_WAIT_V(4); PG8_BAR;
    PG8_STAGE(PG8_SB(1, 0), cB + kstep, voffB); PG8_STAGE(PG8_SA(1, 0), cA + kstep, voffA); PG8_STAGE(PG8_SB(1, 1), cB + hstep + kstep, voffB);
    PG8_WAIT_V(6); PG8_BAR;
    for (;;) {
        const bool has_next = S.next(ui + 1, nxt);
        const char* nA = has_next ? (const char*)g.A + (size_t)nxt.pm * tstep : cA; const char* nB = has_next ? (const char*)g.Bt + (size_t)nxt.pn * tstep : cB;
        for (int t = 0; t < nt; t += 2) {
            const bool last = (t == nt - 2);
            const char* a1 = cA + (size_t)(t + 1) * kstep;
            const char* a2 = last ? nA : cA + (size_t)(t + 2) * kstep; const char* b2 = last ? nB : cB + (size_t)(t + 2) * kstep;
            const char* a3 = a2 + kstep; const char* b3 = b2 + kstep;
            PG8_LDB(B0, 0, 0); PG8_SCHED; PG8_LDA(At, 0, 0); PG8_STAGE(PG8_SA(1, 1), a1 + hstep, voffA);
            PG8_WAIT_L(8); PG8_BAR; PG8_WAIT_L(0); PG8_MMA(0, 0, At, B0); PG8_BAR; PG8_SCHED;
            PG8_LDB(B1, 0, 1); PG8_STAGE(PG8_SB(0, 0), b2, voffB);
            PG8_BAR; PG8_WAIT_L(0); PG8_MMA(0, 1, At, B1); PG8_BAR;
            PG8_LDA(At, 0, 1); PG8_STAGE(PG8_SA(0, 0), a2, voffA);
            PG8_BAR; PG8_WAIT_L(0); PG8_MMA(1, 0, At, B0); PG8_BAR; PG8_SCHED;
            PG8_STAGE(PG8_SB(0, 1), b2 + hstep, voffB);
            PG8_WAIT_V(6); PG8_BAR; PG8_MMA(1, 1, At, B1); PG8_BAR;
            PG8_LDB(B0, 1, 0); PG8_SCHED; PG8_LDA(At, 1, 0); PG8_STAGE(PG8_SA(0, 1), a2 + hstep, voffA);
            PG8_WAIT_L(8); PG8_BAR; PG8_WAIT_L(0); PG8_MMA(0, 0, At, B0); PG8_BAR; PG8_SCHED;
            PG8_LDB(B1, 1, 1); PG8_STAGE(PG8_SB(1, 0), b3, voffB);
            PG8_BAR; PG8_WAIT_L(0); PG8_MMA(0, 1, At, B1); PG8_BAR;
            PG8_LDA(At, 1, 1); PG8_STAGE(PG8_SA(1, 0), a3, voffA);
            PG8_BAR; PG8_WAIT_L(0); PG8_MMA(1, 0, At, B0); PG8_BAR; PG8_SCHED;
            PG8_STAGE(PG8_SB(1, 1), b3 + hstep, voffB);
            PG8_WAIT_V(6); PG8_BAR; PG8_MMA(1, 1, At, B1); PG8_BAR;
        }
        if constexpr (Epi::ALIGN) { if (wr == 0) PG8_BAR; }
        E(acc, cur, wr, wc, fr, fq);
        if (!has_next) break;
#pragma unroll
        for (int a = 0; a < 2; ++a)
#pragma unroll
            for (int b = 0; b < 2; ++b)
#pragma unroll
                for (int m = 0; m < 4; ++m)
#pragma unroll
                    for (int n = 0; n < 2; ++n) acc[a][b][m][n] = (f32x4){0.f, 0.f, 0.f, 0.f};
        cur = nxt; cA = nA; cB = nB; ++ui;
        if constexpr (Epi::ALIGN) { if (wr == 1) PG8_BAR; }
    }
    PG8_WAIT_V(0);
    if constexpr (!Epi::ALIGN) { if (wr == 0) PG8_BAR; }
    PG8_BAR;
#undef PG8_SA
#undef PG8_SB
#undef PG8_STAGE
#undef PG8_LDA
#undef PG8_LDB
#undef PG8_MMA
#undef PG8_WAIT_V
#undef PG8_WAIT_L
#undef PG8_BAR
#undef PG8_SCHED
}
}

__device__ __forceinline__ f32x4 bf4_to_f32(u32x2 h) { return (f32x4){bflo(h.x), bfhi(h.x), bflo(h.y), bfhi(h.y)}; }
__device__ __forceinline__ void norm_rows(int r0, int r1, const float* x_lo_, const float* x_hi_, const bf16_t* xb, const float* g, const float* modv, int sh_off, bf16_t* O, float* Of, int lane) {
    int curv = -1; f32x4 gs[4], shv[4], nx[4];
#pragma unroll
    for (int j = 0; j < 4; ++j) nx[j] = (f32x4){0.f, 0.f, 0.f, 0.f};
    if (r0 < r1) {
        if (xb) { const u32x2* xn = (const u32x2*)(xb + (size_t)r0 * 1024) + lane;
#pragma unroll
            for (int j = 0; j < 4; ++j) nx[j] = bf4_to_f32(xn[64 * j]); }
        else { const f32x4* xn = (const f32x4*)((r0 < T_CTX ? x_lo_ : x_hi_) + (size_t)r0 * 1024) + lane;
#pragma unroll
            for (int j = 0; j < 4; ++j) nx[j] = xn[64 * j]; } }
    for (int m = r0; m < r1; ++m) {
        const int v = m < T_CTX ? 0 : 1 + ((m - T_CTX) >> 10);
        if (v != curv) { curv = v;
#pragma unroll
            for (int j = 0; j < 4; ++j) { const f32x4 gg = ((const f32x4*)g)[lane + 64 * j];
                if (modv) { const f32x4 a = ((const f32x4*)(modv + v * 6144 + sh_off + 1024))[lane + 64 * j]; gs[j] = gg * (a + 1.f); shv[j] = ((const f32x4*)(modv + v * 6144 + sh_off))[lane + 64 * j]; }
                else { gs[j] = gg; shv[j] = (f32x4){0.f, 0.f, 0.f, 0.f}; } } }
        f32x4 vv[4]; float s = 0.f;
#pragma unroll
        for (int j = 0; j < 4; ++j) { vv[j] = nx[j]; s += (vv[j].x * vv[j].x + vv[j].y * vv[j].y) + (vv[j].z * vv[j].z + vv[j].w * vv[j].w); }
        if (m + 1 < r1) {
            if (xb) { const u32x2* xn = (const u32x2*)(xb + (size_t)(m + 1) * 1024) + lane;
#pragma unroll
                for (int j = 0; j < 4; ++j) nx[j] = bf4_to_f32(xn[64 * j]); }
            else { const f32x4* xn = (const f32x4*)((m + 1 < T_CTX ? x_lo_ : x_hi_) + (size_t)(m + 1) * 1024) + lane;
#pragma unroll
                for (int j = 0; j < 4; ++j) nx[j] = xn[64 * j]; } }
        const float rstd = 1.f / sqrtf(wave_sum(s) * (1.f / 1024.f) + 1e-6f);
#pragma unroll
        for (int j = 0; j < 4; ++j) { const f32x4 y = vv[j] * rstd * gs[j] + shv[j];
            if (modv) { u32x2 wv; wv.x = pk2(y.x, y.y); wv.y = pk2(y.z, y.w); ((u32x2*)(O + (size_t)m * 1024))[lane + 64 * j] = wv; }
            else ((f32x4*)(Of + (size_t)m * 1024))[lane + 64 * j] = y; }
    }
}

#define XB_TMO      128
#define XB_XCNT(j)  (256  + 64 * (j))
#define XB_XSUB(j)  (1280 + 64 * (j))
#define XB_XGEN(j)  (2304 + 64 * (j))
#define XB_TOP      3328
#define XB_TOPGEN   3392
#define XCD_BAR_WORDS 3456
#define XB_SPIN_CAP (1u << 18)
__device__ __forceinline__ unsigned xb_ld(unsigned* p)              { return __hip_atomic_load(p, __ATOMIC_RELAXED, __HIP_MEMORY_SCOPE_AGENT); }
__device__ __forceinline__ unsigned xb_add(unsigned* p, unsigned v) { return __hip_atomic_fetch_add(p, v, __ATOMIC_RELAXED, __HIP_MEMORY_SCOPE_AGENT); }
__device__ __forceinline__ unsigned xb_xcc_id() { return (unsigned)__builtin_amdgcn_s_getreg((3 << 11) | 20) & 0xFu; }
#define XB_SPIN(cond, bar) do { unsigned _sp = 0; while (cond) { __builtin_amdgcn_s_sleep(1); \
    if ((++_sp & 255u) == 0u) { if (xb_ld(&(bar)[XB_TMO])) break; if (_sp > XB_SPIN_CAP) { atomicAdd(&(bar)[XB_TMO], 1u); break; } } } } while (0)
__device__ __forceinline__ void xcd_barrier_complete(unsigned* bar, unsigned x, unsigned& nloc, unsigned& nx) {
    const unsigned G = gridDim.x * gridDim.y * gridDim.z;
    unsigned sum, cnt, mine, sp = 0u;
    for (;;) {
        sum = 0u; cnt = 0u; mine = 0u;
#pragma unroll
        for (unsigned j = 0; j < 16; ++j) { const unsigned c = xb_ld(&bar[XB_XCNT(j)]); sum += c; cnt += (c > 0u) ? 1u : 0u; mine = (j == x) ? c : mine; }
        if (sum == G) break;
        __builtin_amdgcn_s_sleep(1);
        if ((++sp & 255u) == 0u) { if (xb_ld(&bar[XB_TMO])) break; if (sp > XB_SPIN_CAP) { atomicAdd(&bar[XB_TMO], 1u); break; } }
    }
    nloc = mine > 0u ? mine : 1u; nx = cnt > 0u ? cnt : 1u;
}
__device__ __forceinline__ void xcd_barrier(unsigned* bar, volatile LAS unsigned* st) {
    asm volatile("s_waitcnt vmcnt(0)" ::: "memory");
    __syncthreads();
    if (threadIdx.x == 0) {
        const unsigned x = xb_xcc_id();
        __builtin_amdgcn_s_waitcnt(0);
        unsigned nloc = st[0], nx = st[1];
        if (nloc == 0u) { xcd_barrier_complete(bar, x, nloc, nx); st[0] = nloc; st[1] = nx; }
        const unsigned old = xb_add(&bar[XB_XSUB(x)], 1u);
        const unsigned gen = old / nloc;
        if (old + 1u == (gen + 1u) * nloc) {
            __builtin_amdgcn_fence(__ATOMIC_RELEASE, "agent");
            asm volatile("s_waitcnt vmcnt(0)" ::: "memory");
            const unsigned og = xb_add(&bar[XB_TOP], 1u);
            const unsigned tg = og / nx;
            if (og + 1u == (tg + 1u) * nx) xb_add(&bar[XB_TOPGEN], 1u);
            else XB_SPIN(xb_ld(&bar[XB_TOPGEN]) == tg, bar);
            __builtin_amdgcn_fence(__ATOMIC_ACQUIRE, "agent");
            xb_add(&bar[XB_XGEN(x)], 1u);
            asm volatile("s_waitcnt vmcnt(0)" ::: "memory");
        } else {
            XB_SPIN(xb_ld(&bar[XB_XGEN(x)]) == gen, bar);
            __builtin_amdgcn_fence(__ATOMIC_ACQUIRE, "agent");
            asm volatile("s_waitcnt vmcnt(0)" ::: "memory");
        }
    }
    __syncthreads();
}

struct Args {
    const float* in[28];
    float* out; unsigned char* ws;
    int ph_lo, ph_hi;
};
enum { I_XP = 0, I_XS, I_STATE, I_CK, I_CV, I_C, I_CCTX, I_ADAW, I_ADAB, I_NMG, I_NFG, I_WIN, I_CONVW, I_CONVB, I_DTB, I_ALOG, I_DSK, I_SNG, I_SCW, I_WMO,
       I_WQKV, I_RPB, I_WNAO, I_WG, I_WU, I_FCW, I_WD, I_FNG };

__device__ __forceinline__ void transpose_item(const float* W, int K, int N, bf16_t* WT, int kind, LAS float* scr, int item, int lane) {
    const int nblk = N / 32, kb = item / nblk, nb = item % nblk, k0 = 64 * kb, n0 = 32 * nb;
    int r0;
    if (kind == 0) r0 = n0;
    else if (kind == 1) {
        if (n0 < 2560) r0 = n0; else if (n0 < 2592) r0 = n0 + 3072; else if (n0 < 3616) r0 = n0 - 32;
        else if (n0 < 4640) { const int c = n0 - 3616; r0 = 3584 + 256 * (c >> 7) + (c & 127); }
        else { const int c = n0 - 4640; r0 = 3584 + 256 * (c >> 7) + 128 + (c & 127); } }
    else if (kind == 2) r0 = 256 * (n0 >> 7) + (n0 & 127);
    else r0 = 256 * (n0 >> 7) + 128 + (n0 & 127);
#pragma unroll 8
    for (int i = 0; i < 32; ++i) { const int kk = 2 * i + (lane >> 5); scr[kk * 33 + (lane & 31)] = W[(size_t)(k0 + kk) * N + n0 + (lane & 31)]; }
    asm volatile("s_waitcnt lgkmcnt(0)" ::: "memory");
    const int c = lane & 7;
#pragma unroll
    for (int j = 0; j < 4; ++j) { const int n = (lane >> 3) + 8 * j; const LAS float* s = scr + (8 * c) * 33 + n;
        u32x4 o; o.x = pk2(s[0 * 33], s[1 * 33]); o.y = pk2(s[2 * 33], s[3 * 33]); o.z = pk2(s[4 * 33], s[5 * 33]); o.w = pk2(s[6 * 33], s[7 * 33]);
        *(u32x4*)(WT + (size_t)(r0 + n) * K + k0 + 8 * c) = o; }
    asm volatile("s_waitcnt lgkmcnt(0)" ::: "memory");
}

__device__ __forceinline__ void norm_row(const float* xrow, const float* g, const float* sh, const float* sc, bf16_t* orow, float* orow_f32, int lane) {
    const f32x4* xr = (const f32x4*)xrow + lane;
    f32x4 v[4]; float s = 0.f;
#pragma unroll
    for (int j = 0; j < 4; ++j) { v[j] = xr[64 * j]; s += (v[j].x * v[j].x + v[j].y * v[j].y) + (v[j].z * v[j].z + v[j].w * v[j].w); }
    const float rstd = 1.f / sqrtf(wave_sum(s) * (1.f / 1024.f) + 1e-6f);
#pragma unroll
    for (int j = 0; j < 4; ++j) {
        const f32x4 gg = ((const f32x4*)g)[lane + 64 * j];
        f32x4 y = v[j] * rstd * gg;
        if (sc) { const f32x4 a = ((const f32x4*)sc)[lane + 64 * j], b = ((const f32x4*)sh)[lane + 64 * j]; y = y * (a + 1.f) + b;
            u32x2 w; w.x = pk2(y.x, y.y); w.y = pk2(y.z, y.w); ((u32x2*)orow)[lane + 64 * j] = w; }
        else ((f32x4*)orow_f32)[lane + 64 * j] = y;
    }
}

#ifndef PROBE_MASK
#define PROBE_MASK 0u
#endif
#define REP(k) for (int rep_ = 0; rep_ < ((((unsigned)PROBE_MASK >> (k)) & 1u) ? 2 : 1); ++rep_)
#ifndef SKIP_SSD
#define SKIP_SSD 0
#endif
#ifndef SKIP_ATT
#define SKIP_ATT 0
#endif
#ifndef SKIP_NA
#define SKIP_NA 0
#endif
#define PHASE_IDS() unsigned char* ws = args.ws; asm volatile("" : "+s"(ws)); int tid_ = threadIdx.x; asm volatile("" : "+v"(tid_)); const int tid = tid_, lane = tid & 63, wave = __builtin_amdgcn_readfirstlane(tid >> 6); \
    const int gw = bx * NWAVES + wave, NGW = G * NWAVES; const size_t gt = (size_t)bx * NTHREADS + tid, NGT = (size_t)G * NTHREADS; (void)lane; (void)gw; (void)NGW; (void)gt; (void)NGT;
#define PHASE_WS() unsigned char* ws = args.ws; asm volatile("" : "+s"(ws));
#define MOD ((float*)(ws + WS_MOD))
#define WIN ((bf16_t*)(ws + WS_WIN))
#define WMO ((bf16_t*)(ws + WS_WMO))
#define WQKV ((bf16_t*)(ws + WS_WQKV))
#define WNAO ((bf16_t*)(ws + WS_WNAO))
#define Zb ((bf16_t*)(ws + WS_Z))
#define XR ((bf16_t*)(ws + WS_XR))
#define BCX ((bf16_t*)(ws + WS_BCX))
#define GU ((bf16_t*)(ws + WS_GU))
#define QKV ((bf16_t*)(ws + WS_QKV))
#define YB ((bf16_t*)(ws + WS_YB))
#define YPART ((bf16_t*)(ws + WS_YPART))
#define XC ((bf16_t*)(ws + WS_XC))
#define YCAT ((bf16_t*)(ws + WS_YCAT))
#define Hb ((bf16_t*)(ws + WS_H))
#define ACT ((bf16_t*)(ws + WS_ACT))
#define ATT ((bf16_t*)(ws + WS_ATT))
#define DTRAW ((float*)(ws + WS_DTRAW))
#define DT ((float*)(ws + WS_DT))
#define OUTY (args.out + OUT_Y)
#define XB ((bf16_t*)(ws + WS_XB))
#define x_lo (args.in[I_XP])
#define x_hi (args.in[I_XS] - (size_t)T_CTX * 1024)
#define IN(k) (lo <= (k) && (k) < hi)
#define MISC_OFF (LDS_BYTES - 64)
#define SEAM(k) do { if (IN(k) && IN((k) + 1)) xcd_barrier((unsigned*)(args.ws + WS_BAR), (volatile LAS unsigned*)(lds + MISC_OFF)); } while (0)


__device__ __forceinline__ int mat_items(int id) { return id == 0 ? 16 * 177 : id == 1 ? 32 * 32 : id <= 5 ? 16 * 88 : id <= 7 ? 44 * 32 : id == 8 ? 16 * 96 : 16 * 32; }
__device__ __forceinline__ void mat_item(const Args& args, unsigned char* ws, int id, int r, LAS float* scr, int lane) {
    if (id == 0) transpose_item(args.in[I_WIN], 1024, NIN_SRC, (bf16_t*)(ws + WS_WIN), 1, scr, r, lane);
    else if (id == 1) transpose_item(args.in[I_WMO], 2048, 1024, (bf16_t*)(ws + WS_WMO), 0, scr, r, lane);
    else if (id <= 5) { const int q = id - 2, layer = q >> 1, up = q & 1;
        transpose_item(args.in[up ? I_WU : I_WG] + (size_t)layer * 1024 * DFF, 1024, DFF, (bf16_t*)(ws + (layer ? WS_WGU1 : WS_WGU0)), 2 + up, scr, r, lane); }
    else if (id <= 7) { const int layer = id - 6;
        transpose_item(args.in[I_WD] + (size_t)layer * DFF * 1024, DFF, 1024, (bf16_t*)(ws + (layer ? WS_WDN1 : WS_WDN0)), 0, scr, r, lane); }
    else if (id == 8) transpose_item(args.in[I_WQKV], 1024, NQKV, (bf16_t*)(ws + WS_WQKV), 0, scr, r, lane);
    else transpose_item(args.in[I_WNAO], 1024, 1024, (bf16_t*)(ws + WS_WNAO), 0, scr, r, lane);
}
template <int STAGE>
__device__ __forceinline__ void prep_stage(const Args& args, LAS unsigned char* lds, const int vb, const int nvb) {
    unsigned char* ws = args.ws; int tid_ = threadIdx.x; asm volatile("" : "+v"(tid_)); const int tid = tid_, lane = tid & 63, wave = __builtin_amdgcn_readfirstlane(tid >> 6);
    constexpr int ada_layer = STAGE == 0 ? 0 : (STAGE == 2 ? 1 : -1);
    if (ada_layer >= 0) {
        LAS float* sv = (LAS float*)lds;
        LAS float* red = (LAS float*)(lds + 12288);
        for (int i = tid; i < 3072; i += NTHREADS) { const int v = i >> 10, k = i & 1023; const float c = v == 0 ? args.in[I_CCTX][k] : args.in[I_C][(v - 1) * 1024 + k]; sv[i] = silu_f(c); }
        __syncthreads();
        for (int cc = vb; cc < 96; cc += nvb) {
            const int layer = ada_layer;
            const int sub = lane >> 4, c4 = (lane & 15) * 4;
            const float* wp = args.in[I_ADAW] + ((size_t)layer * 1024 + wave * 128 + sub) * 6144 + cc * 64 + c4;
            f32x4 a0 = {0.f, 0.f, 0.f, 0.f}, a1 = a0, a2 = a0;
#pragma unroll 8
            for (int it = 0; it < 32; ++it) { const f32x4 w4 = *(const f32x4*)(wp + (size_t)it * 4 * 6144); const int k = wave * 128 + it * 4 + sub;
                a0 += w4 * sv[k]; a1 += w4 * sv[1024 + k]; a2 += w4 * sv[2048 + k]; }
#pragma unroll
            for (int e = 0; e < 4; ++e) { a0[e] += __shfl_xor(a0[e], 16); a0[e] += __shfl_xor(a0[e], 32); a1[e] += __shfl_xor(a1[e], 16); a1[e] += __shfl_xor(a1[e], 32); a2[e] += __shfl_xor(a2[e], 16); a2[e] += __shfl_xor(a2[e], 32); }
            if (lane < 16) { *(LAS f32x4*)(red + (wave * 3 + 0) * 64 + c4) = a0; *(LAS f32x4*)(red + (wave * 3 + 1) * 64 + c4) = a1; *(LAS f32x4*)(red + (wave * 3 + 2) * 64 + c4) = a2; }
            __syncthreads();
            if (tid < 192) { const int v = tid >> 6, c = tid & 63; float s = args.in[I_ADAB][layer * 6144 + cc * 64 + c];
#pragma unroll
                for (int w = 0; w < 8; ++w) s += red[(w * 3 + v) * 64 + c];
                ((float*)(ws + WS_MOD))[(layer * 3 + v) * 6144 + cc * 64 + c] = s; }
            __syncthreads();
        }
    }
    LAS float* scr = (LAS float*)(lds + 32768 + wave * 8448);
    constexpr int NID = STAGE == 0 ? 2 : (STAGE == 1 ? 3 : 5);
    constexpr int IDS[3][5] = {{0, 1, 0, 0, 0}, {2, 3, 6, 0, 0}, {4, 5, 7, 8, 9}};
    int total = 0;
#pragma unroll
    for (int j = 0; j < NID; ++j) total += mat_items(IDS[STAGE][j]);
    for (int it = vb * NWAVES + wave; it < total; it += nvb * NWAVES) {
        int r = it;
#pragma unroll
        for (int j = 0; j < NID; ++j) { const int n = mat_items(IDS[STAGE][j]); if (r >= 0 && r < n) mat_item(args, ws, IDS[STAGE][j], r, scr, lane); r -= n; }
    }
    if (STAGE == 0) { u32x4* z = (u32x4*)((bf16_t*)(ws + WS_WIN) + (size_t)NIN_SRC * 1024); const size_t n16 = (size_t)(NIN - NIN_SRC) * 1024 * 2 / 16;
        for (size_t i = (size_t)vb * NTHREADS + tid; i < n16; i += (size_t)nvb * NTHREADS) z[i] = (u32x4){0u, 0u, 0u, 0u}; }
    __syncthreads();
}

template <int layer>
__device__ __forceinline__ void layer_body(const Args& args, LAS unsigned char* lds, cg::grid_group& grid, const int lo, const int hi) {
    const int G = gridDim.x, bx = blockIdx.x;
        const int pb = 1 + layer * 10;
#define modl (MOD + layer * 3 * 6144)
        REP(pb) if (IN(pb)) {
            PHASE_IDS();
            const float* g = args.in[I_NMG] + layer * 1024;
            { const int rpw = (T + NGW - 1) / NGW, r0 = gw * rpw, r1 = min(T, r0 + rpw);
              norm_rows(r0, r1, x_lo, x_hi, layer == 0 ? (const bf16_t*)nullptr : (const bf16_t*)XB, g, modl, 0, Hb, nullptr, lane); }
        }
        SEAM(pb);
        if constexpr (layer == 0) {
            if (IN(2)) { PHASE_WS(); pg8::Gemm g{Hb, WIN, T, NIN, 1024}; pg8::StaticOrder S; S.init(T, NIN, G, bx); pg8::EpiIn E{Zb, XR, BCX, DTRAW}; pg8::gemm_phase(lds, g, S, E); }
            if constexpr (false) {}
            if ((((unsigned)PROBE_MASK >> (2)) & 1u)) if (IN(2)) { PHASE_WS(); pg8::Gemm g{Hb, WIN, T, NIN, 1024}; pg8::StaticOrder S; S.init(T, NIN, G, bx); pg8::EpiIn E{Zb, XR, BCX, DTRAW}; pg8::gemm_phase(lds, g, S, E); }
            SEAM(2);
            REP(3) if (IN(3)) {
                PHASE_IDS();
                const float* cw = args.in[I_CONVW]; const float* cb = args.in[I_CONVB]; const float* scw = args.in[I_SCW]; const float* dtb = args.in[I_DTB];
                const int ntask = (T / 8) * 320;
                for (int idx = (int)gt; idx < ntask; idx += (int)NGT) {
                    const int rbk = idx / 320, j = idx % 320, t0 = rbk * 8;
                    const int pos0 = t0 < T_CTX ? (t0 & 255) : ((t0 - T_CTX) & 1023), len = t0 < T_CTX ? 256 : 1024;
                    const bool hp = pos0 > 0, hn = pos0 + 8 < len;
                    const u32x4 z4 = {0u, 0u, 0u, 0u};
                    if (j < 192) {
                        const int c0 = 8 * j; const bf16_t* p = XR + (size_t)t0 * 1536 + c0;
                        float wa[8], wb[8], wc_[8], bb[8];
#pragma unroll
                        for (int q = 0; q < 2; ++q) { const f32x4 t0_ = *(const f32x4*)(cw + c0 + 4 * q), t1_ = *(const f32x4*)(cw + 1536 + c0 + 4 * q), t2_ = *(const f32x4*)(cw + 3072 + c0 + 4 * q), t3_ = *(const f32x4*)(cb + c0 + 4 * q);
#pragma unroll
                            for (int e = 0; e < 4; ++e) { wa[4 * q + e] = t0_[e]; wb[4 * q + e] = t1_[e]; wc_[4 * q + e] = t2_[e]; bb[4 * q + e] = t3_[e]; } }
                        u32x4 vr[10];
                        vr[0] = hp ? *(const u32x4*)(p - 1536) : z4;
#pragma unroll
                        for (int r = 0; r < 8; ++r) vr[r + 1] = *(const u32x4*)(p + (size_t)r * 1536);
                        vr[9] = hn ? *(const u32x4*)(p + (size_t)8 * 1536) : z4;
#pragma unroll
                        for (int r = 0; r < 8; ++r) {
                            const u32x4 vm = vr[r], v0 = vr[r + 1], vp = vr[r + 2];
                            float o[8];
#pragma unroll
                            for (int e = 0; e < 4; ++e) {
                                o[2 * e] = silu_f(wa[2 * e] * bflo(vm[e]) + wb[2 * e] * bflo(v0[e]) + wc_[2 * e] * bflo(vp[e]) + bb[2 * e]);
                                o[2 * e + 1] = silu_f(wa[2 * e + 1] * bfhi(vm[e]) + wb[2 * e + 1] * bfhi(v0[e]) + wc_[2 * e + 1] * bfhi(vp[e]) + bb[2 * e + 1]); }
                            u32x4 w; w.x = pk2(o[0], o[1]); w.y = pk2(o[2], o[3]); w.z = pk2(o[4], o[5]); w.w = pk2(o[6], o[7]);
                            *(u32x4*)(XC + (size_t)(t0 + r) * 1536 + c0) = w;
                        }
                    } else {
                        const int c0 = 8 * (j - 192); const bf16_t* p = BCX + (size_t)t0 * 3072 + c0;
                        float wa[8], wb[8], wc_[8];
#pragma unroll
                        for (int q = 0; q < 2; ++q) { const f32x4 t0_ = *(const f32x4*)(scw + c0 + 4 * q), t1_ = *(const f32x4*)(scw + 1024 + c0 + 4 * q), t2_ = *(const f32x4*)(scw + 2048 + c0 + 4 * q);
#pragma unroll
                            for (int e = 0; e < 4; ++e) { wa[4 * q + e] = t0_[e]; wb[4 * q + e] = t1_[e]; wc_[4 * q + e] = t2_[e]; } }
#pragma unroll
                        for (int hf = 0; hf < 2; ++hf) {
                            u32x4 cr[6], bgr[4];
#pragma unroll
                            for (int k = 0; k < 6; ++k) { const int rr = 4 * hf - 1 + k; const bool ok = (rr >= 0 || hp) && (rr <= 7 || hn);
                                cr[k] = ok ? *(const u32x4*)(p + (ptrdiff_t)rr * 3072 + 1024) : z4; }
#pragma unroll
                            for (int k = 0; k < 4; ++k) bgr[k] = *(const u32x4*)(p + (size_t)(4 * hf + k) * 3072);
                            float pr[6][8];
#pragma unroll
                            for (int k = 0; k < 6; ++k)
#pragma unroll
                                for (int e = 0; e < 4; ++e) { pr[k][2 * e] = bflo(cr[k][e]); pr[k][2 * e + 1] = bfhi(cr[k][e]); }
#pragma unroll
                            for (int k = 0; k < 4; ++k) {
                                float o[8];
#pragma unroll
                                for (int e = 0; e < 4; ++e) {
                                    o[2 * e] = bflo(bgr[k][e]) * (wa[2 * e] * pr[k][2 * e] + wb[2 * e] * pr[k + 1][2 * e] + wc_[2 * e] * pr[k + 2][2 * e]);
                                    o[2 * e + 1] = bfhi(bgr[k][e]) * (wa[2 * e + 1] * pr[k][2 * e + 1] + wb[2 * e + 1] * pr[k + 1][2 * e + 1] + wc_[2 * e + 1] * pr[k + 2][2 * e + 1]); }
                                u32x4 w; w.x = pk2(o[0], o[1]); w.y = pk2(o[2], o[3]); w.z = pk2(o[4], o[5]); w.w = pk2(o[6], o[7]);
                                *(u32x4*)(YCAT + (size_t)(t0 + 4 * hf + k) * 2048 + 1024 + c0) = w;
                            }
                        }
                    }
                }
                for (size_t idx = gt; idx < (size_t)T * 8; idx += NGT) {
                    const f32x4 r_ = *(const f32x4*)(DTRAW + idx * 4), b_ = *(const f32x4*)(dtb + (idx & 7) * 4); f32x4 d_;
#pragma unroll
                    for (int e = 0; e < 4; ++e) { const float xv = r_[e] + b_[e]; d_[e] = xv > 20.f ? xv : log1pf(expf(xv)); }
                    *(f32x4*)(DT + idx * 4) = d_;
                }
            }
            SEAM(3);
            REP(4)
            if (IN(4) && !SKIP_SSD) {
                PHASE_IDS();
                constexpr int LS = 136;
                LAS bf16_t* sC = (LAS bf16_t*)lds;
                LAS bf16_t* sB = (LAS bf16_t*)(lds + 34816);
                LAS bf16_t* sBt = (LAS bf16_t*)(lds + 2 * 34816);
                LAS bf16_t* sXt = (LAS bf16_t*)(lds + 3 * 34816);
                LAS bf16_t* sH = (LAS bf16_t*)(lds + 3 * 34816 + 17408);
                LAS float* sArr = (LAS float*)(lds + 3 * 34816 + 2 * 17408);
                LAS float* sIf = sArr, *sSb = sArr + 128, *sDtf = sArr + 256, *sDtb = sArr + 384, *sWf = sArr + 512, *sWb = sArr + 640, *sEf = sArr + 768, *sEb = sArr + 896, *sScal = sArr + 1024;
                const int fr = lane & 15, fq = lane >> 4, w = wave;
                const float* alog = args.in[I_ALOG]; const float* dsk = args.in[I_DSK];
                for (int uu = 0;; ++uu) {
                    int ui;
                    if (G == 256) { if (bx < 64) { if (uu > 1) break; ui = uu == 0 ? bx : 64 + bx; } else { if (uu > 4) break; ui = 128 + (bx - 64) + 192 * uu; } }
                    else { ui = bx + uu * G; if (ui >= 1088) break; }
                    int seq_t0, nc, h, bctx = -1, blat = -1, pass;
                    if (ui < 64) { blat = ui >> 5; h = (ui >> 1) & 15; pass = ui & 1; seq_t0 = T_CTX + blat * 1024; nc = 8; }
                    else { const int ci = ui - 64; bctx = ci >> 5; h = (ci >> 1) & 15; pass = ci & 1; seq_t0 = bctx * 256; nc = 2; }
                    const int grp = h >> 3;
                    const float a_f = -expf(alog[h]), a_b = -expf(alog[16 + h]);
                    {
                        f32x4 hst[4];
#pragma unroll
                        for (int pt = 0; pt < 4; ++pt) {
                            if (blat >= 0) hst[pt] = *(const f32x4*)(args.in[I_STATE] + ((((size_t)blat * 2 + pass) * 16 + h) * 64 + 16 * pt + fr) * 128 + 16 * w + 4 * fq);
                            else hst[pt] = (f32x4){0.f, 0.f, 0.f, 0.f};
                            u32x2 pk; pk.x = pk2(hst[pt][0], hst[pt][1]); pk.y = pk2(hst[pt][2], hst[pt][3]);
                            *(LAS u32x2*)(sH + (16 * pt + fr) * LS + 16 * w + 4 * fq) = pk;
                        }
                        u32x4 rC[4], rB[4], rX[2]; float rd0 = 0.f, rd1 = 0.f;
#define SSD_PREFETCH(cidx) do { const int t0p = seq_t0 + 128 * (cidx); \
                            _Pragma("unroll") for (int i = 0; i < 4; ++i) { const int idx = tid + 512 * i, l = idx >> 4, n8 = (idx & 15) * 8; rC[i] = *(const u32x4*)(XC + (size_t)(t0p + l) * 1536 + 1280 + grp * 128 + n8); } \
                            _Pragma("unroll") for (int i = 0; i < 4; ++i) { const int idx = tid + 512 * i, l = idx & 127, n8 = (idx >> 7) * 8; rB[i] = *(const u32x4*)(XC + (size_t)(t0p + l) * 1536 + 1024 + grp * 128 + n8); } \
                            _Pragma("unroll") for (int i = 0; i < 2; ++i) { const int idx = tid + 512 * i, l = idx & 127, p8 = (idx >> 7) * 8; rX[i] = *(const u32x4*)(XC + (size_t)(t0p + l) * 1536 + h * 64 + p8); } \
                            if (w < 2) { rd0 = DT[(size_t)(t0p + 2 * lane) * 32 + w * 16 + h]; rd1 = DT[(size_t)(t0p + 2 * lane + 1) * 32 + w * 16 + h]; } } while (0)
                        SSD_PREFETCH(pass == 0 ? 0 : nc - 1);
                        for (int cc = 0; cc < nc; ++cc) {
                            const int c = pass == 0 ? cc : nc - 1 - cc;
                            const int t0 = seq_t0 + 128 * c;
                            f32x4 Y[4];
#pragma unroll
                            for (int pt = 0; pt < 4; ++pt) Y[pt] = (f32x4){0.f, 0.f, 0.f, 0.f};
#pragma unroll
                            for (int i = 0; i < 4; ++i) { const int idx = tid + 512 * i, l = idx >> 4, n8 = (idx & 15) * 8; *(LAS u32x4*)(sC + l * LS + n8) = rC[i]; }
#pragma unroll
                            for (int i = 0; i < 4; ++i) { const int idx = tid + 512 * i, l = idx & 127, n8 = (idx >> 7) * 8;
                                const u32x4 vb = rB[i];
                                if (pass == 0) *(LAS u32x4*)(sB + l * LS + n8) = vb;
#pragma unroll
                                for (int e = 0; e < 4; ++e) { sBt[(n8 + 2 * e) * LS + l] = (bf16_t)(vb[e] & 0xffffu); sBt[(n8 + 2 * e + 1) * LS + l] = (bf16_t)(vb[e] >> 16); } }
#pragma unroll
                            for (int i = 0; i < 2; ++i) { const int idx = tid + 512 * i, l = idx & 127, p8 = (idx >> 7) * 8;
                                const u32x4 vx = rX[i];
#pragma unroll
                                for (int e = 0; e < 4; ++e) { sXt[(p8 + 2 * e) * LS + l] = (bf16_t)(vx[e] & 0xffffu); sXt[(p8 + 2 * e + 1) * LS + l] = (bf16_t)(vx[e] >> 16); } }
                            if (w < 2) {
                                const float av = w == 0 ? a_f : a_b;
                                const float d0 = rd0, d1 = rd1;
                                const float e0 = d0 * av, e1 = d1 * av;
                                float s = e0 + e1;
#pragma unroll
                                for (int o = 1; o < 64; o <<= 1) { const float tt = __shfl_up(s, o); if (lane >= o) s += tt; }
                                const float tot = __shfl(s, 63);
                                if (w == 0) { const float i1 = s, i0 = s - e1;
                                    sIf[2 * lane] = i0; sIf[2 * lane + 1] = i1; sDtf[2 * lane] = d0; sDtf[2 * lane + 1] = d1;
                                    sWf[2 * lane] = __expf(tot - i0) * d0; sWf[2 * lane + 1] = __expf(tot - i1) * d1; sEf[2 * lane] = __expf(i0); sEf[2 * lane + 1] = __expf(i1);
                                    if (lane == 0) sScal[0] = __expf(tot);
                                } else { const float s0 = tot - (s - e0 - e1), s1 = tot - (s - e1);
                                    sSb[2 * lane] = s0; sSb[2 * lane + 1] = s1; sDtb[2 * lane] = d0; sDtb[2 * lane + 1] = d1;
                                    sWb[2 * lane] = __expf(tot - s0) * d0; sWb[2 * lane + 1] = __expf(tot - s1) * d1; sEb[2 * lane] = __expf(s0); sEb[2 * lane + 1] = __expf(s1);
                                    if (lane == 0) sScal[1] = __expf(tot);
                                }
                            }
                            LDS_BARRIER();
                            if (cc + 1 < nc) SSD_PREFETCH(pass == 0 ? cc + 1 : nc - 2 - cc);
                            const int l = 16 * w + fr;
                            bf16x8 cfrag[4];
#pragma unroll
                            for (int ks = 0; ks < 4; ++ks) cfrag[ks] = *(const LAS bf16x8*)(sC + l * LS + 32 * ks + 8 * fq);
                            if (pass == 0) {
#pragma unroll
                                for (int pt = 0; pt < 4; ++pt) Y[pt] = (f32x4){0.f, 0.f, 0.f, 0.f};
                                const float If_l = sIf[l], Sb_l = sSb[l];
#pragma unroll
                                for (int u = 0; u < 4; ++u) {
                                    unsigned mw[4];
#pragma unroll
                                    for (int hh = 0; hh < 2; ++hh) {
                                        const int st = 2 * u + hh;
                                        f32x4 gacc = {0.f, 0.f, 0.f, 0.f};
#pragma unroll
                                        for (int ks = 0; ks < 4; ++ks) { const bf16x8 bfrag = *(const LAS bf16x8*)(sB + (16 * st + fr) * LS + 32 * ks + 8 * fq); gacc = MFMA16(bfrag, cfrag[ks], gacc); }
                                        const int s0 = 16 * st + 4 * fq;
                                        f32x4 fac = {0.f, 0.f, 0.f, 0.f};
                                        if (st <= w) { const f32x4 is = *(const LAS f32x4*)(sIf + s0), ds = *(const LAS f32x4*)(sDtf + s0);
#pragma unroll
                                            for (int e = 0; e < 4; ++e) fac[e] += (s0 + e <= l) ? __expf(fminf(If_l - is[e], 0.f)) * ds[e] : 0.f; }
                                        if (st >= w) { const f32x4 ss = *(const LAS f32x4*)(sSb + s0), ds = *(const LAS f32x4*)(sDtb + s0);
#pragma unroll
                                            for (int e = 0; e < 4; ++e) fac[e] += (s0 + e >= l) ? __expf(fminf(Sb_l - ss[e], 0.f)) * ds[e] : 0.f; }
                                        gacc = gacc * fac;
                                        mw[2 * hh] = pk2(gacc[0], gacc[1]); mw[2 * hh + 1] = pk2(gacc[2], gacc[3]);
                                    }
                                    u32x4 mf = {mw[0], mw[1], mw[2], mw[3]};
                                    const bf16x8 mfrag = __builtin_bit_cast(bf16x8, mf);
#pragma unroll
                                    for (int pt = 0; pt < 4; ++pt) {
                                        const u32x2 xa = *(const LAS u32x2*)(sXt + (16 * pt + fr) * LS + 32 * u + 4 * fq), xb = *(const LAS u32x2*)(sXt + (16 * pt + fr) * LS + 32 * u + 16 + 4 * fq);
                                        u32x4 xf = {xa.x, xa.y, xb.x, xb.y};
                                        Y[pt] = MFMA16(__builtin_bit_cast(bf16x8, xf), mfrag, Y[pt]);
                                    }
                                }
                            }
                            if (!(bctx >= 0 && cc == 0)) {
                                const float el = pass == 0 ? sEf[l] : sEb[l];
#pragma unroll
                                for (int pt = 0; pt < 4; ++pt) { f32x4 yi = {0.f, 0.f, 0.f, 0.f};
#pragma unroll
                                    for (int ks = 0; ks < 4; ++ks) { const bf16x8 hf = *(const LAS bf16x8*)(sH + (16 * pt + fr) * LS + 32 * ks + 8 * fq); yi = MFMA16(hf, cfrag[ks], yi); }
                                    Y[pt] += yi * el; }
                            }
                            {
                                bf16_t* yp = (pass == 0 ? YPART : YB) + ((((size_t)(t0 >> 7)) * 16 + h) * 512 + tid) * 16;
                                u32x4 y0, y1;
                                y0.x = pk2(Y[0][0], Y[0][1]); y0.y = pk2(Y[0][2], Y[0][3]); y0.z = pk2(Y[1][0], Y[1][1]); y0.w = pk2(Y[1][2], Y[1][3]);
                                y1.x = pk2(Y[2][0], Y[2][1]); y1.y = pk2(Y[2][2], Y[2][3]); y1.z = pk2(Y[3][0], Y[3][1]); y1.w = pk2(Y[3][2], Y[3][3]);
                                *(u32x4*)yp = y0; *(u32x4*)(yp + 8) = y1;
                            }
                            LDS_BARRIER();
                            {
                                const float dec = sScal[pass];
                                const LAS float* sW = pass == 0 ? sWf : sWb;
#pragma unroll
                                for (int pt = 0; pt < 4; ++pt) hst[pt] = hst[pt] * dec;
#pragma unroll
                                for (int ks = 0; ks < 4; ++ks) {
                                    const u32x4 br = *(const LAS u32x4*)(sBt + (16 * w + fr) * LS + 32 * ks + 8 * fq);
                                    const f32x4 w0 = *(const LAS f32x4*)(sW + 32 * ks + 8 * fq), w1 = *(const LAS f32x4*)(sW + 32 * ks + 8 * fq + 4);
                                    u32x4 bs; bs.x = pk2(bflo(br.x) * w0[0], bfhi(br.x) * w0[1]); bs.y = pk2(bflo(br.y) * w0[2], bfhi(br.y) * w0[3]);
                                    bs.z = pk2(bflo(br.z) * w1[0], bfhi(br.z) * w1[1]); bs.w = pk2(bflo(br.w) * w1[2], bfhi(br.w) * w1[3]);
                                    const bf16x8 bfrag = __builtin_bit_cast(bf16x8, bs);
#pragma unroll
                                    for (int pt = 0; pt < 4; ++pt) {
                                        const bf16x8 xf = *(const LAS bf16x8*)(sXt + (16 * pt + fr) * LS + 32 * ks + 8 * fq);
                                        hst[pt] = MFMA16(bfrag, xf, hst[pt]);
                                    }
                                }
#pragma unroll
                                for (int pt = 0; pt < 4; ++pt) { u32x2 pk; pk.x = pk2(hst[pt][0], hst[pt][1]); pk.y = pk2(hst[pt][2], hst[pt][3]);
                                    *(LAS u32x2*)(sH + (16 * pt + fr) * LS + 16 * w + 4 * fq) = pk; }
                            }
                            LDS_BARRIER();
                        }
                        if (bctx >= 0) {
                            float* so = args.out + OUT_STATE + ((((size_t)bctx * 2 + pass) * 16 + h) * 64) * 128;
#pragma unroll
                            for (int pt = 0; pt < 4; ++pt) *(f32x4*)(so + (size_t)(16 * pt + fr) * 128 + 16 * w + 4 * fq) = hst[pt];
                        }
                    }
                }
            }
            SEAM(4);
            REP(5) if (IN(5)) {
                PHASE_IDS();
                const float* g = args.in[I_SNG]; const float* dsk = args.in[I_DSK];
                const int hh = lane >> 2, fq = lane & 3;
                const float Dsum = dsk[hh] + dsk[16 + hh];
                for (int m = gw; m < T; m += NGW) {
                    const int gc = m >> 7, l = m & 127, w = l >> 4, fr = l & 15;
                    const size_t base = ((((size_t)gc * 16 + hh) * 512) + w * 64 + fq * 16 + fr) * 16;
                    f32x4 y[4]; float ss = 0.f;
#pragma unroll
                    for (int pt = 0; pt < 4; ++pt) {
                        const int c0 = hh * 64 + 16 * pt + 4 * fq;
                        const u32x2 yfp = *(const u32x2*)(YPART + base + 4 * pt), ybp = *(const u32x2*)(YB + base + 4 * pt);
                        const float yf[4] = {bflo(yfp.x), bfhi(yfp.x), bflo(yfp.y), bfhi(yfp.y)}, yb[4] = {bflo(ybp.x), bfhi(ybp.x), bflo(ybp.y), bfhi(ybp.y)};
                        const u32x2 xv = *(const u32x2*)(XC + (size_t)m * 1536 + c0), zv = *(const u32x2*)(Zb + (size_t)m * 1024 + c0);
                        const float xs[4] = {bflo(xv.x), bfhi(xv.x), bflo(xv.y), bfhi(xv.y)}, zs[4] = {bflo(zv.x), bfhi(zv.x), bflo(zv.y), bfhi(zv.y)};
#pragma unroll
                        for (int e = 0; e < 4; ++e) { const float o = (yf[e] + yb[e] + xs[e] * Dsum) * silu_f(zs[e]); y[pt][e] = o; ss += o * o; }
                    }
                    const float rstd = 1.f / sqrtf(wave_sum(ss) * (1.f / 1024.f) + 1e-6f);
#pragma unroll
                    for (int pt = 0; pt < 4; ++pt) { const int c0 = hh * 64 + 16 * pt + 4 * fq; const f32x4 gg = *(const f32x4*)(g + c0);
                        u32x2 o; o.x = pk2(y[pt][0] * rstd * gg[0], y[pt][1] * rstd * gg[1]); o.y = pk2(y[pt][2] * rstd * gg[2], y[pt][3] * rstd * gg[3]);
                        *(u32x2*)(YCAT + (size_t)m * 2048 + c0) = o; }
                }
            }
            SEAM(5);
            if (IN(6)) { if (G > 160 && bx >= 160) prep_stage<1>(args, lds, bx - 160, G - 160); else { PHASE_WS(); pg8::Gemm g{YCAT, WMO, T, 1024, 2048}; pg8::StaticOrder S; S.init(T, 1024, G, bx); pg8::EpiResB<true> E{x_lo, x_hi, nullptr, XB, modl + 2048}; pg8::gemm_phase(lds, g, S, E); } if (G <= 160) prep_stage<1>(args, lds, bx, G); }
            if constexpr (false) {}
            if ((((unsigned)PROBE_MASK >> (6)) & 1u)) if (IN(6)) { PHASE_WS(); pg8::Gemm g{YCAT, WMO, T, 1024, 2048}; pg8::StaticOrder S; S.init(T, 1024, G, bx); pg8::EpiRes E{x_lo, x_hi, OUTY, modl + 2048}; pg8::gemm_phase(lds, g, S, E); }
            SEAM(6);
        } else {
            if (IN(12)) { PHASE_WS(); pg8::Gemm g{Hb, WQKV, T, NQKV, 1024}; pg8::StaticOrder S; S.init(T, NQKV, G, bx); pg8::EpiQKV E{QKV, args.out + OUT_K, args.out + OUT_V}; pg8::gemm_phase(lds, g, S, E); }
            if constexpr (false) {}
            if ((((unsigned)PROBE_MASK >> (12)) & 1u)) if (IN(12)) { PHASE_WS(); pg8::Gemm g{Hb, WQKV, T, NQKV, 1024}; pg8::StaticOrder S; S.init(T, NQKV, G, bx); pg8::EpiQKV E{QKV, args.out + OUT_K, args.out + OUT_V}; pg8::gemm_phase(lds, g, S, E); }
            SEAM(12);
            REP(13)
            if (IN(13) && !SKIP_ATT) {
                PHASE_IDS();
                const int fr = lane & 15, fq = lane >> 4, w = wave;
                const float SCL = 0.125f * 1.4426950408889634f;
                for (int unit = bx; unit < 256 && !SKIP_NA; unit += G) {
                    const int b = unit >> 7, h = (unit >> 3) & 15, rp = unit & 7;
                    const int r = 2 * rp + (w >> 2), j = w & 3;
                    const int rb = min(max(2 * rp - 4, 0), 8), rs = min(max(r - 4, 0), 8), ro = rs - rb;
                    const int cs = min(max(16 * j - 8, 0), 32);
                    constexpr int KS = 72;
                    LAS bf16_t* sKc = (LAS bf16_t*)lds;
                    LAS bf16_t* sKl = (LAS bf16_t*)(lds + 36864);
                    LAS float* sRpb = (LAS float*)(lds + 36864 + 82944);
                    const size_t tokb = (size_t)T_CTX + (size_t)b * 1024;
                    for (int idx = tid; idx < 256 * 8; idx += NTHREADS) { const int key = idx >> 3, d8 = (idx & 7) * 8;
                        const float* src = args.in[I_CK] + (((size_t)b * 256 + key) * 16 + h) * 64 + d8;
                        const f32x4 a = *(const f32x4*)src, c = *(const f32x4*)(src + 4);
                        u32x4 o; o.x = pk2(a[0], a[1]); o.y = pk2(a[2], a[3]); o.z = pk2(c[0], c[1]); o.w = pk2(c[2], c[3]);
                        *(LAS u32x4*)(sKc + key * KS + d8) = o; }
                    for (int idx = tid; idx < 576 * 8; idx += NTHREADS) { const int key = idx >> 3, d8 = (idx & 7) * 8; const int gr = rb + (key >> 6);
                        if (gr < 16) *(LAS u32x4*)(sKl + key * KS + d8) = *(const u32x4*)(QKV + (tokb + gr * 64 + (key & 63)) * NQKV + 1024 + h * 64 + d8); }
                    for (int idx = tid; idx < 465; idx += NTHREADS) sRpb[idx] = args.in[I_RPB][h * 465 + idx];
                    __syncthreads();
                    const size_t qtok = tokb + r * 64 + 16 * j + fr;
                    bf16x8 qf[2];
#pragma unroll
                    for (int ks = 0; ks < 2; ++ks) qf[ks] = *(const bf16x8*)(QKV + qtok * NQKV + h * 64 + 32 * ks + 8 * fq);
                    unsigned P1[8][4], P2[8][4]; float m1, l1, m2, l2;
                    {
                        f32x4 sc[16];
#pragma unroll
                        for (int t = 0; t < 16; ++t) { f32x4 a = {0.f, 0.f, 0.f, 0.f};
#pragma unroll
                            for (int ks = 0; ks < 2; ++ks) { const bf16x8 kf = *(const LAS bf16x8*)(sKc + (16 * t + fr) * KS + 32 * ks + 8 * fq); a = MFMA16(kf, qf[ks], a); }
                            sc[t] = a * SCL; }
                        float mx = -1e30f;
#pragma unroll
                        for (int t = 0; t < 16; ++t)
#pragma unroll
                            for (int e = 0; e < 4; ++e) mx = fmaxf(mx, sc[t][e]);
                        mx = fmaxf(mx, __shfl_xor(mx, 16)); mx = fmaxf(mx, __shfl_xor(mx, 32));
                        float sum = 0.f;
#pragma unroll
                        for (int t = 0; t < 16; ++t)
#pragma unroll
                            for (int e = 0; e < 4; ++e) { const float p = __builtin_amdgcn_exp2f(sc[t][e] - mx); sc[t][e] = p; sum += p; }
                        sum += __shfl_xor(sum, 16); sum += __shfl_xor(sum, 32);
                        m1 = mx; l1 = sum;
#pragma unroll
                        for (int u = 0; u < 8; ++u) { P1[u][0] = pk2(sc[2 * u][0], sc[2 * u][1]); P1[u][1] = pk2(sc[2 * u][2], sc[2 * u][3]); P1[u][2] = pk2(sc[2 * u + 1][0], sc[2 * u + 1][1]); P1[u][3] = pk2(sc[2 * u + 1][2], sc[2 * u + 1][3]); }
                    }
                    {
                        const int qcol = 16 * j + fr, cstart = min(max(qcol - 8, 0), 48);
                        f32x4 sc[16];
#pragma unroll
                        for (int t = 0; t < 16; ++t) { f32x4 a = {0.f, 0.f, 0.f, 0.f};
                            const int kr = t >> 1, kc0 = 16 * (t & 1);
#pragma unroll
                            for (int ks = 0; ks < 2; ++ks) { const bf16x8 kf = *(const LAS bf16x8*)(sKl + ((ro + kr) * 64 + cs + kc0 + fr) * KS + 32 * ks + 8 * fq); a = MFMA16(kf, qf[ks], a); }
                            const int dr = rs + kr - r + 7;
#pragma unroll
                            for (int e = 0; e < 4; ++e) { const int col = cs + kc0 + 4 * fq + e; const int dc = min(max(col - qcol + 15, 0), 30);
                                const bool ok = col >= cstart && col < cstart + 16;
                                a[e] = ok ? (a[e] * 0.125f + sRpb[dr * 31 + dc]) * 1.4426950408889634f : -1e30f; }
                            sc[t] = a; }
                        float mx = -1e30f;
#pragma unroll
                        for (int t = 0; t < 16; ++t)
#pragma unroll
                            for (int e = 0; e < 4; ++e) mx = fmaxf(mx, sc[t][e]);
                        mx = fmaxf(mx, __shfl_xor(mx, 16)); mx = fmaxf(mx, __shfl_xor(mx, 32));
                        float sum = 0.f;
#pragma unroll
                        for (int t = 0; t < 16; ++t)
#pragma unroll
                            for (int e = 0; e < 4; ++e) { const float p = __builtin_amdgcn_exp2f(sc[t][e] - mx); sc[t][e] = p; sum += p; }
                        sum += __shfl_xor(sum, 16); sum += __shfl_xor(sum, 32);
                        m2 = mx; l2 = sum;
#pragma unroll
                        for (int u = 0; u < 8; ++u) { P2[u][0] = pk2(sc[2 * u][0], sc[2 * u][1]); P2[u][1] = pk2(sc[2 * u][2], sc[2 * u][3]); P2[u][2] = pk2(sc[2 * u + 1][0], sc[2 * u + 1][1]); P2[u][3] = pk2(sc[2 * u + 1][2], sc[2 * u + 1][3]); }
                    }
                    const float mm = fmaxf(m1, m2), f1 = __builtin_amdgcn_exp2f(m1 - mm), f2 = __builtin_amdgcn_exp2f(m2 - mm);
                    const float inv = 1.f / (l1 * f1 + l2 * f2), g1 = f1 * inv, g2 = f2 * inv;
                    __syncthreads();
                    constexpr int VCS = 264, VLS = 584;
                    LAS bf16_t* sVc = (LAS bf16_t*)lds;
                    LAS bf16_t* sVl = (LAS bf16_t*)(lds + 33792);
                    for (int idx = tid; idx < 256 * 8; idx += NTHREADS) { const int key = idx & 255, d8 = (idx >> 8) * 8;
                        const float* src = args.in[I_CV] + (((size_t)b * 256 + key) * 16 + h) * 64 + d8;
                        const f32x4 a = *(const f32x4*)src, c = *(const f32x4*)(src + 4);
#pragma unroll
                        for (int e = 0; e < 4; ++e) { sVc[(d8 + e) * VCS + key] = (bf16_t)f2bf(a[e]); sVc[(d8 + 4 + e) * VCS + key] = (bf16_t)f2bf(c[e]); } }
                    for (int idx = tid; idx < 576 * 8; idx += NTHREADS) { const int key = idx % 576, d8 = (idx / 576) * 8; const int gr = rb + (key >> 6);
                        if (gr < 16) { const u32x4 v = *(const u32x4*)(QKV + (tokb + gr * 64 + (key & 63)) * NQKV + 2048 + h * 64 + d8);
#pragma unroll
                            for (int e = 0; e < 4; ++e) { sVl[(d8 + 2 * e) * VLS + key] = (bf16_t)(v[e] & 0xffffu); sVl[(d8 + 2 * e + 1) * VLS + key] = (bf16_t)(v[e] >> 16); } } }
                    __syncthreads();
                    f32x4 O1[4], O2[4];
#pragma unroll
                    for (int dt = 0; dt < 4; ++dt) { O1[dt] = (f32x4){0.f, 0.f, 0.f, 0.f}; O2[dt] = (f32x4){0.f, 0.f, 0.f, 0.f}; }
#pragma unroll
                    for (int u = 0; u < 8; ++u) {
                        const u32x4 pf = {P1[u][0], P1[u][1], P1[u][2], P1[u][3]};
#pragma unroll
                        for (int dt = 0; dt < 4; ++dt) { const u32x2 va = *(const LAS u32x2*)(sVc + (16 * dt + fr) * VCS + 32 * u + 4 * fq), vb = *(const LAS u32x2*)(sVc + (16 * dt + fr) * VCS + 32 * u + 16 + 4 * fq);
                            u32x4 vf = {va.x, va.y, vb.x, vb.y}; O1[dt] = MFMA16(__builtin_bit_cast(bf16x8, vf), __builtin_bit_cast(bf16x8, pf), O1[dt]); }
                    }
#pragma unroll
                    for (int u = 0; u < 8; ++u) {
                        const u32x4 pf = {P2[u][0], P2[u][1], P2[u][2], P2[u][3]};
                        const int kb = (ro + u) * 64 + cs + 4 * fq;
#pragma unroll
                        for (int dt = 0; dt < 4; ++dt) { const u32x2 va = *(const LAS u32x2*)(sVl + (16 * dt + fr) * VLS + kb), vb = *(const LAS u32x2*)(sVl + (16 * dt + fr) * VLS + kb + 16);
                            u32x4 vf = {va.x, va.y, vb.x, vb.y}; O2[dt] = MFMA16(__builtin_bit_cast(bf16x8, vf), __builtin_bit_cast(bf16x8, pf), O2[dt]); }
                    }
#pragma unroll
                    for (int dt = 0; dt < 4; ++dt) { const f32x4 o = O1[dt] * g1 + O2[dt] * g2; u32x2 pk; pk.x = pk2(o[0], o[1]); pk.y = pk2(o[2], o[3]);
                        *(u32x2*)(ATT + qtok * 1024 + h * 64 + 16 * dt + 4 * fq) = pk; }
                    __syncthreads();
                }
                for (int unit = bx; unit < 512; unit += G) {
                    const int b = unit >> 4, h = unit & 15;
                    constexpr int KS = 72, VS = 264;
                    LAS bf16_t* sK = (LAS bf16_t*)lds;
                    LAS bf16_t* sVt = (LAS bf16_t*)(lds + 36864);
                    const size_t tokb = (size_t)b * 256;
                    for (int idx = tid; idx < 256 * 8; idx += NTHREADS) { const int key = idx >> 3, d8 = (idx & 7) * 8;
                        *(LAS u32x4*)(sK + key * KS + d8) = *(const u32x4*)(QKV + (tokb + key) * NQKV + 1024 + h * 64 + d8); }
                    for (int idx = tid; idx < 256 * 8; idx += NTHREADS) { const int key = idx & 255, d8 = (idx >> 8) * 8;
                        const u32x4 v = *(const u32x4*)(QKV + (tokb + key) * NQKV + 2048 + h * 64 + d8);
#pragma unroll
                        for (int e = 0; e < 4; ++e) { sVt[(d8 + 2 * e) * VS + key] = (bf16_t)(v[e] & 0xffffu); sVt[(d8 + 2 * e + 1) * VS + key] = (bf16_t)(v[e] >> 16); } }
                    __syncthreads();
                    for (int qt = 0; qt < 2; ++qt) {
                        const size_t qtok = tokb + 32 * w + 16 * qt + fr;
                        bf16x8 qf[2];
#pragma unroll
                        for (int ks = 0; ks < 2; ++ks) qf[ks] = *(const bf16x8*)(QKV + qtok * NQKV + h * 64 + 32 * ks + 8 * fq);
                        f32x4 sc[16];
#pragma unroll
                        for (int t = 0; t < 16; ++t) { f32x4 a = {0.f, 0.f, 0.f, 0.f};
#pragma unroll
                            for (int ks = 0; ks < 2; ++ks) { const bf16x8 kf = *(const LAS bf16x8*)(sK + (16 * t + fr) * KS + 32 * ks + 8 * fq); a = MFMA16(kf, qf[ks], a); }
                            sc[t] = a * SCL; }
                        float mx = -1e30f;
#pragma unroll
                        for (int t = 0; t < 16; ++t)
#pragma unroll
                            for (int e = 0; e < 4; ++e) mx = fmaxf(mx, sc[t][e]);
                        mx = fmaxf(mx, __shfl_xor(mx, 16)); mx = fmaxf(mx, __shfl_xor(mx, 32));
                        float sum = 0.f;
#pragma unroll
                        for (int t = 0; t < 16; ++t)
#pragma unroll
                            for (int e = 0; e < 4; ++e) { const float p = __builtin_amdgcn_exp2f(sc[t][e] - mx); sc[t][e] = p; sum += p; }
                        sum += __shfl_xor(sum, 16); sum += __shfl_xor(sum, 32);
                        const float inv = 1.f / sum;
                        f32x4 O[4];
#pragma unroll
                        for (int dt = 0; dt < 4; ++dt) O[dt] = (f32x4){0.f, 0.f, 0.f, 0.f};
#pragma unroll
                        for (int u = 0; u < 8; ++u) {
                            u32x4 pf; pf.x = pk2(sc[2 * u][0], sc[2 * u][1]); pf.y = pk2(sc[2 * u][2], sc[2 * u][3]); pf.z = pk2(sc[2 * u + 1][0], sc[2 * u + 1][1]); pf.w = pk2(sc[2 * u + 1][2], sc[2 * u + 1][3]);
#pragma unroll
                            for (int dt = 0; dt < 4; ++dt) { const u32x2 va = *(const LAS u32x2*)(sVt + (16 * dt + fr) * VS + 32 * u + 4 * fq), vb = *(const LAS u32x2*)(sVt + (16 * dt + fr) * VS + 32 * u + 16 + 4 * fq);
                                u32x4 vf = {va.x, va.y, vb.x, vb.y}; O[dt] = MFMA16(__builtin_bit_cast(bf16x8, vf), __builtin_bit_cast(bf16x8, pf), O[dt]); }
                        }
#pragma unroll
                        for (int dt = 0; dt < 4; ++dt) { u32x2 pk; pk.x = pk2(O[dt][0] * inv, O[dt][1] * inv); pk.y = pk2(O[dt][2] * inv, O[dt][3] * inv);
                            *(u32x2*)(ATT + qtok * 1024 + h * 64 + 16 * dt + 4 * fq) = pk; }
                    }
                    __syncthreads();
                }
            }
            SEAM(13);
            if (IN(14)) { PHASE_WS(); pg8::Gemm g{ATT, WNAO, T, 1024, 1024}; pg8::StaticOrder S; S.init(T, 1024, G, bx); pg8::EpiResB<false> E{nullptr, nullptr, XB, XB, modl + 2048}; pg8::gemm_phase(lds, g, S, E); }
            SEAM(14);
        }
        const int pf = layer == 0 ? 7 : 15;
        REP(pf) if (IN(pf)) {
            PHASE_IDS();
            const float* g = args.in[I_NFG] + layer * 1024;
            { const int rpw = (T + NGW - 1) / NGW, r0 = gw * rpw, r1 = min(T, r0 + rpw);
              norm_rows(r0, r1, nullptr, nullptr, XB, g, modl, 3072, Hb, nullptr, lane); }
            const bf16_t* WG = (const bf16_t*)(ws + (layer ? WS_WGU1 : WS_WGU0));
            float* HALO = (float*)(ws + WS_HALO);
            for (int it = gw; it < 12 * 176; it += NGW) {
                const int hr = it / 176, cb = it % 176;
                const int sq = hr / 6, kk = (hr % 6) >> 1, side = hr & 1;
                const int m = T_CTX + sq * 1024 + 256 * (kk + 1) - 1 + side;
                const float* sh = modl + (1 + sq) * 6144 + 3072; const float* sc = modl + (1 + sq) * 6144 + 4096;
                const u32x2* xr = (const u32x2*)(XB + (size_t)m * 1024) + lane;
                f32x4 v[4]; float ss = 0.f;
#pragma unroll
                for (int j = 0; j < 4; ++j) { v[j] = bf4_to_f32(xr[64 * j]); ss += (v[j].x * v[j].x + v[j].y * v[j].y) + (v[j].z * v[j].z + v[j].w * v[j].w); }
                const float rstd = 1.f / sqrtf(wave_sum(ss) * (1.f / 1024.f) + 1e-6f);
#pragma unroll
                for (int j = 0; j < 4; ++j) { const f32x4 gg = ((const f32x4*)g)[lane + 64 * j], a = ((const f32x4*)sc)[lane + 64 * j], b = ((const f32x4*)sh)[lane + 64 * j];
                    const f32x4 y = v[j] * rstd * gg * (a + 1.f) + b; const unsigned p0 = pk2(y.x, y.y), p1 = pk2(y.z, y.w);
                    v[j] = (f32x4){bflo(p0), bfhi(p0), bflo(p1), bfhi(p1)}; }
#pragma unroll
                for (int cbat = 0; cbat < 2; ++cbat) {
                    u32x2 wv[8][4];
#pragma unroll
                    for (int c = 0; c < 8; ++c) { const int gc = cb * 16 + cbat * 8 + c; const bf16_t* wrow = WG + (size_t)(256 * (gc >> 7) + (gc & 127)) * 1024;
#pragma unroll
                        for (int j = 0; j < 4; ++j) wv[c][j] = ((const u32x2*)wrow)[lane + 64 * j]; }
                    float dd[8];
#pragma unroll
                    for (int c = 0; c < 8; ++c) { float d = 0.f;
#pragma unroll
                        for (int j = 0; j < 4; ++j) d += v[j].x * bflo(wv[c][j].x) + v[j].y * bfhi(wv[c][j].x) + v[j].z * bflo(wv[c][j].y) + v[j].w * bfhi(wv[c][j].y);
                        dd[c] = wave_sum(d); }
                    if (lane == 0) { float* hp_ = HALO + (size_t)hr * DFF + cb * 16 + cbat * 8;
                        *(f32x4*)hp_ = (f32x4){dd[0], dd[1], dd[2], dd[3]}; *(f32x4*)(hp_ + 4) = (f32x4){dd[4], dd[5], dd[6], dd[7]}; }
                }
            }
        }
        SEAM(pf);
        if (IN(pf + 1)) { PHASE_WS(); pg8::Gemm g{Hb, (const bf16_t*)(ws + (layer ? WS_WGU1 : WS_WGU0)), T, NGU, 1024}; pg8::StaticOrder S; S.init(T, NGU, G, bx); pg8::EpiGUF E{ACT, args.in[I_FCW] + (size_t)layer * 3 * DFF, (const float*)(ws + WS_HALO), (LAS float*)(lds + 131072)}; pg8::gemm_phase(lds, g, S, E); }
        if constexpr (false) {}
        if ((((unsigned)PROBE_MASK >> ((pf + 1))) & 1u)) if (IN(pf + 1)) { PHASE_WS(); pg8::Gemm g{Hb, (const bf16_t*)(ws + (layer ? WS_WGU1 : WS_WGU0)), T, NGU, 1024}; pg8::StaticOrder S; S.init(T, NGU, G, bx); pg8::EpiGUF E{ACT, args.in[I_FCW] + (size_t)layer * 3 * DFF, (const float*)(ws + WS_HALO), (LAS float*)(lds + 131072)}; pg8::gemm_phase(lds, g, S, E); }
        SEAM(pf + 1);
        if (IN(pf + 3)) { if (layer == 0 && G > 160 && bx >= 160) prep_stage<2>(args, lds, bx - 160, G - 160); else { PHASE_WS(); pg8::Gemm g{ACT, (const bf16_t*)(ws + (layer ? WS_WDN1 : WS_WDN0)), T, 1024, DFF}; pg8::StaticOrder S; S.init(T, 1024, G, bx); pg8::EpiResB<false> E{nullptr, nullptr, XB, XB, modl + 5120}; pg8::gemm_phase(lds, g, S, E); } if (layer == 0 && G <= 160) prep_stage<2>(args, lds, bx, G); }
        SEAM(pf + 3);

}

__global__ void __launch_bounds__(NTHREADS, 2) fwd_mega(Args args) {
    extern __shared__ __attribute__((aligned(16))) unsigned char lds_raw[];
    LAS unsigned char* lds = (LAS unsigned char*)lds_raw;
    cg::grid_group grid = cg::this_grid();
    const int G = gridDim.x, bx = blockIdx.x;
    const int lo = args.ph_lo, hi = args.ph_hi;
    if (threadIdx.x < 16) ((volatile LAS unsigned*)(lds + MISC_OFF))[threadIdx.x] = 0u;
    __syncthreads();
    if (hi - lo > 1 && threadIdx.x == 0) (void)xb_add(&((unsigned*)(args.ws + WS_BAR))[XB_XCNT(xb_xcc_id())], 1u);
    if (hi > 1000) grid.sync();
    if (IN(0)) prep_stage<0>(args, lds, blockIdx.x, gridDim.x);
    SEAM(0);

    layer_body<0>(args, lds, grid, lo, hi);
    layer_body<1>(args, lds, grid, lo, hi);
    if (IN(19)) {
        PHASE_IDS();
        const float* g = args.in[I_FNG];
        { const int rpw = (T + NGW - 1) / NGW, r0 = gw * rpw, r1 = min(T, r0 + rpw); norm_rows(r0, r1, nullptr, nullptr, XB, g, nullptr, 0, nullptr, OUTY, lane); }
    }
#undef IN
#undef SEAM
}

#ifndef N_LAUNCH_PER_PHASE
#define N_LAUNCH_PER_PHASE 0
#endif
extern "C" void kernel_launch(void* const* d_in, const int* in_sizes, int n_in, void* d_out, int out_size, void* d_ws, size_t ws_size, hipStream_t stream) {
    static int grid = 0;
    if (grid == 0) {
        if (n_in != 28 || ws_size < WS_END) { fprintf(stderr, "kernel_launch: unexpected n_in %d or ws %zu (< %zu)\n", n_in, ws_size, (size_t)WS_END); grid = -1; return; }
        int dev = 0, cus = 0, per_cu = 0;
        hipGetDevice(&dev); hipDeviceGetAttribute(&cus, hipDeviceAttributeMultiprocessorCount, dev);
        if (hipFuncSetAttribute((const void*)fwd_mega, hipFuncAttributeMaxDynamicSharedMemorySize, LDS_BYTES) != hipSuccess) { fprintf(stderr, "hipFuncSetAttribute failed\n"); grid = -1; return; }
        if (hipOccupancyMaxActiveBlocksPerMultiprocessor(&per_cu, (const void*)fwd_mega, NTHREADS, LDS_BYTES) != hipSuccess || per_cu < 1) { fprintf(stderr, "occupancy query: %d\n", per_cu); per_cu = 1; }
        (void)hipGetLastError();
        grid = cus;
    }
    if (grid < 0) return;
    if (hipMemsetAsync((char*)d_ws + WS_BAR, 0, 16384, stream) != hipSuccess) { fprintf(stderr, "memset failed\n"); return; }
    Args a{};
    for (int i = 0; i < 28; ++i) a.in[i] = (const float*)d_in[i];
    a.out = (float*)d_out; a.ws = (unsigned char*)d_ws;
#if N_LAUNCH_PER_PHASE
    for (int ph = 0; ph < 20; ++ph) { a.ph_lo = ph; a.ph_hi = ph + 1; hipLaunchKernelGGL(fwd_mega, dim3(grid), dim3(NTHREADS), LDS_BYTES, stream, a); }
#else
    a.ph_lo = 0; a.ph_hi = 20;
    void* kargs[] = {&a};
    hipError_t e = hipLaunchCooperativeKernel((const void*)fwd_mega, dim3(grid), dim3(NTHREADS), kargs, LDS_BYTES, stream);
    if (e != hipSuccess) fprintf(stderr, "cooperative launch failed: %s (grid %d)\n", hipGetErrorString(e), grid);
#endif
}
```
